# Optimizing an MI355X kernel written in HIP

```python
import math
import jax, jax.numpy as jnp
from jax import lax
import numpy as np

D_MODEL = 1024
BATCH = 2
SEQ = 8192
DEPTH = 4

GRID_W = 64
CTX_LEN = 256
EPS = 1e-6

GDN_QK_HEADS = 8
GDN_V_HEADS = 16
GDN_HEAD_DIM = 128
GDN_QK_W = GDN_QK_HEADS * GDN_HEAD_DIM
GDN_V_W = GDN_V_HEADS * GDN_HEAD_DIM
GDN_QKV_W = 2 * GDN_QK_W + GDN_V_W
GDN_IN_W = GDN_QKV_W + GDN_V_W + 4 * GDN_V_HEADS
GDN_CHUNK = 64

LRU_W = D_MODEL
LRU_BLOCKS = 4
LRU_BS = LRU_W // LRU_BLOCKS
RG_C = 8.0

CONV_W = 4
CONV_LEFT = 2

N_GDN = (DEPTH + 1) // 2
N_LRU = DEPTH // 2

kernel_name = "hybrid_gdn_rglru_prefix_dit"


def rmsnorm(x, g):
    xf = x.astype(jnp.float32)
    y = xf * lax.rsqrt(jnp.mean(xf * xf, axis=-1, keepdims=True) + EPS)
    return y.astype(x.dtype) * g


def l2norm(x):
    xf = x.astype(jnp.float32)
    return (xf * lax.rsqrt(jnp.sum(xf * xf, axis=-1, keepdims=True) + EPS)).astype(x.dtype)


def short_conv(x, w):
    T = x.shape[1]
    xp = jnp.pad(x, ((0, 0), (CONV_LEFT, CONV_W - 1 - CONV_LEFT), (0, 0)))
    out = xp[:, 0:T] * w[0]
    for j in range(1, CONV_W):
        out = out + xp[:, j:j + T] * w[j]
    return out


def to_col_major(t, rows):
    B, T, D = t.shape
    return t.reshape(B, rows, GRID_W, D).transpose(0, 2, 1, 3).reshape(B, T, D)


def from_col_major(t, rows):
    B, T, D = t.shape
    return t.reshape(B, GRID_W, rows, D).transpose(0, 2, 1, 3).reshape(B, T, D)


def chunk_gated_delta(q, k, v, g, beta, s0):
    out_dtype = v.dtype
    q, k, v, g, beta = (t.astype(jnp.float32) for t in (q, k, v, g, beta))
    B, T, H, DK = q.shape
    DV = v.shape[-1]
    C = GDN_CHUNK
    N = T // C
    ch = lambda t: t.reshape(B, N, C, H, -1).transpose(0, 3, 1, 2, 4)
    q, k, v = ch(q), ch(k), ch(v)
    g = g.reshape(B, N, C, H).transpose(0, 3, 1, 2)
    beta = beta.reshape(B, N, C, H).transpose(0, 3, 1, 2)
    g = jnp.cumsum(g, axis=-1)
    tril = jnp.tril(jnp.ones((C, C), bool))
    strict = jnp.tril(jnp.ones((C, C), bool), -1)
    diff = g[..., :, None] - g[..., None, :]
    decay = jnp.where(tril, jnp.exp(jnp.where(tril, diff, 0.0)), 0.0)
    kb = k * beta[..., None]
    L = jnp.where(strict, jnp.einsum('bhncd,bhnsd->bhncs', kb, k) * decay, 0.0)
    eye = jnp.eye(C, dtype=jnp.float32)
    rhs = jnp.concatenate([v * beta[..., None], kb * jnp.exp(g)[..., None]], axis=-1)
    sol = lax.linalg.triangular_solve(eye + L, rhs, left_side=True, lower=True, unit_diagonal=True)
    u, w = sol[..., :DV], sol[..., DV:]
    qk = jnp.where(tril, jnp.einsum('bhncd,bhnsd->bhncs', q, k) * decay, 0.0)
    q_dec = q * jnp.exp(g)[..., None]
    k_dec = k * jnp.exp(g[..., -1:] - g)[..., None]
    g_last = jnp.exp(g[..., -1])

    def step(S, xs):
        qk_i, u_i, w_i, qd_i, kd_i, gl_i = xs
        v_new = u_i - jnp.einsum('bhcd,bhde->bhce', w_i, S)
        o = jnp.einsum('bhcd,bhde->bhce', qd_i, S) + jnp.einsum('bhcs,bhse->bhce', qk_i, v_new)
        S = S * gl_i[..., None, None] + jnp.einsum('bhcd,bhce->bhde', kd_i, v_new)
        return S, o

    xs = tuple(jnp.moveaxis(t, 2, 0) for t in (qk, u, w, q_dec, k_dec, g_last))
    S, o = lax.scan(step, s0.astype(jnp.float32), xs)
    o = o.transpose(1, 0, 3, 2, 4).reshape(B, T, H, DV)
    return o.astype(out_dtype), S


def gdn_sequence(h, w_in, conv_w, a_log, dt_bias, norm_g, w_out, s0):
    B, T, _ = h.shape
    proj = h @ w_in
    qkv, z, ab = jnp.split(proj, [GDN_QKV_W, GDN_QKV_W + GDN_V_W], axis=-1)
    qkv = jax.nn.silu(short_conv(qkv, conv_w))
    q, k, v = jnp.split(qkv, [GDN_QK_W, 2 * GDN_QK_W], axis=-1)
    rep = GDN_V_HEADS // GDN_QK_HEADS
    q = jnp.repeat(l2norm(q.reshape(B, T, GDN_QK_HEADS, GDN_HEAD_DIM)) * (GDN_HEAD_DIM ** -0.5), rep, axis=2)
    k = jnp.repeat(l2norm(k.reshape(B, T, GDN_QK_HEADS, GDN_HEAD_DIM)), rep, axis=2)
    v = v.reshape(B, T, GDN_V_HEADS, GDN_HEAD_DIM)
    ab = ab.reshape(B, T, 2, 2, GDN_V_HEADS).astype(jnp.float32)
    g = -jnp.exp(a_log) * jax.nn.softplus(ab[..., 0, :] + dt_bias)
    beta = jax.nn.sigmoid(ab[..., 1, :])
    o_f, s_f = chunk_gated_delta(q, k, v, g[:, :, 0], beta[:, :, 0], s0[0])
    fl = lambda t: jnp.flip(t, axis=1)
    o_b, s_b = chunk_gated_delta(fl(q), fl(k), fl(v), fl(g[:, :, 1]), fl(beta[:, :, 1]), s0[1])
    o = o_f + fl(o_b)
    o = rmsnorm(o, norm_g) * jax.nn.silu(z).reshape(B, T, GDN_V_HEADS, GDN_HEAD_DIM)
    y = o.reshape(B, T, GDN_V_W) @ w_out
    return y, jnp.stack([s_f, s_b])


def gdn_mixer(h_ctx, h_lat, w_in, conv_w, a_log, dt_bias, norm_g, w_out):
    B = h_ctx.shape[0]
    s0 = jnp.zeros((2, B, GDN_V_HEADS, GDN_HEAD_DIM, GDN_HEAD_DIM), jnp.float32)
    y_ctx, s_ctx = gdn_sequence(h_ctx, w_in, conv_w, a_log, dt_bias, norm_g, w_out, s0)
    y_lat, _ = gdn_sequence(h_lat, w_in, conv_w, a_log, dt_bias, norm_g, w_out, s_ctx)
    return y_ctx, y_lat


def linear_scan(a, b, h0):
    def combine(l, r):
        return (l[0] * r[0], r[0] * l[1] + r[1])
    a_cum, h = lax.associative_scan(combine, (a, b), axis=1)
    return a_cum * h0[:, None] + h


def rglru_sequence(h, w_in, conv_w, conv_b, w_r, b_r, w_i, b_i, lam, w_out, h0):
    B, T, _ = h.shape
    xb, gate = jnp.split(h @ w_in, [LRU_W], axis=-1)
    xc = short_conv(xb, conv_w) + conv_b
    xblk = xc.reshape(B, T, LRU_BLOCKS, LRU_BS)
    r = jax.nn.sigmoid(jnp.einsum('btnc,dncs->btdns', xblk, w_r).reshape(B, T, 2, LRU_W) + b_r)
    i = jax.nn.sigmoid(jnp.einsum('btnc,dncs->btdns', xblk, w_i).reshape(B, T, 2, LRU_W) + b_i)
    log_a = -RG_C * r.astype(jnp.float32) * jax.nn.softplus(-lam.astype(jnp.float32))
    a = jnp.exp(log_a)
    b = jnp.sqrt(-jnp.expm1(2.0 * log_a)) * (i.astype(jnp.float32) * xc.astype(jnp.float32)[:, :, None])
    h_f = linear_scan(a[:, :, 0], b[:, :, 0], h0[0])
    h_b = jnp.flip(linear_scan(jnp.flip(a[:, :, 1], 1), jnp.flip(b[:, :, 1], 1), h0[1]), 1)
    y = ((h_f + h_b).astype(h.dtype) * jax.nn.silu(gate)) @ w_out
    return y, jnp.stack([h_f[:, -1], h_b[:, 0]])


def rglru_mixer(h_ctx, h_lat, w_in, conv_w, conv_b, w_r, b_r, w_i, b_i, lam, w_out):
    B = h_ctx.shape[0]
    h0 = jnp.zeros((2, B, LRU_W), jnp.float32)
    y_ctx, h_ctx_state = rglru_sequence(h_ctx, w_in, conv_w, conv_b, w_r, b_r, w_i, b_i, lam, w_out, h0)
    y_lat, _ = rglru_sequence(h_lat, w_in, conv_w, conv_b, w_r, b_r, w_i, b_i, lam, w_out, h_ctx_state)
    return y_ctx, y_lat


def setup_inputs(seed: int = 0) -> dict:
    key = jax.random.key(seed)
    ks = jax.random.split(key, 24)
    nrm = lambda k, shape, s: jax.random.normal(k, shape, jnp.float32) * s
    x = nrm(ks[0], (BATCH, SEQ, D_MODEL), 1.0)
    c = nrm(ks[1], (BATCH, D_MODEL), 1.0)
    ctx = nrm(ks[2], (BATCH, CTX_LEN, D_MODEL), 1.0)
    c_ctx = nrm(ks[3], (D_MODEL,), 1.0)
    mod_w = nrm(ks[4], (DEPTH, D_MODEL, 3 * D_MODEL), 0.5 * D_MODEL ** -0.5)
    mod_b = nrm(ks[5], (DEPTH, 3 * D_MODEL), 0.02)
    norm_g = 1.0 + nrm(ks[6], (DEPTH, D_MODEL), 0.02)
    gdn_w_in = nrm(ks[7], (N_GDN, D_MODEL, GDN_IN_W), D_MODEL ** -0.5)
    gdn_conv = nrm(ks[8], (N_GDN, CONV_W, GDN_QKV_W), CONV_W ** -0.5)
    gdn_a_log = jnp.log(jax.random.uniform(ks[9], (N_GDN, 2, GDN_V_HEADS), jnp.float32, 1.0, 16.0))
    dt = jnp.exp(jax.random.uniform(ks[10], (N_GDN, 2, GDN_V_HEADS), jnp.float32, math.log(1e-3), math.log(1e-1)))
    gdn_dt_bias = dt + jnp.log(-jnp.expm1(-dt))
    gdn_norm_g = 1.0 + nrm(ks[11], (N_GDN, GDN_HEAD_DIM), 0.02)
    gdn_w_out = nrm(ks[12], (N_GDN, GDN_V_W, D_MODEL), GDN_V_W ** -0.5)
    lru_w_in = nrm(ks[13], (N_LRU, D_MODEL, 2 * LRU_W), D_MODEL ** -0.5)
    lru_conv_w = nrm(ks[14], (N_LRU, CONV_W, LRU_W), CONV_W ** -0.5)
    lru_conv_b = nrm(ks[15], (N_LRU, LRU_W), 0.02)
    lru_w_r = nrm(ks[16], (N_LRU, 2, LRU_BLOCKS, LRU_BS, LRU_BS), LRU_BS ** -0.5)
    lru_b_r = nrm(ks[17], (N_LRU, 2, LRU_W), 0.02)
    lru_w_i = nrm(ks[18], (N_LRU, 2, LRU_BLOCKS, LRU_BS, LRU_BS), LRU_BS ** -0.5)
    lru_b_i = nrm(ks[19], (N_LRU, 2, LRU_W), 0.02)
    a0 = jax.random.uniform(ks[20], (N_LRU, 2, LRU_W), jnp.float32, 0.9, 0.999)
    s = a0 ** (1.0 / RG_C)
    lru_lambda = jnp.log(s) - jnp.log1p(-s)
    lru_w_out = nrm(ks[21], (N_LRU, LRU_W, D_MODEL), LRU_W ** -0.5)
    final_g = 1.0 + nrm(ks[22], (D_MODEL,), 0.02)
    return {"x": x, "c": c, "ctx": ctx, "c_ctx": c_ctx,
            "mod_w": mod_w, "mod_b": mod_b, "norm_g": norm_g,
            "gdn_w_in": gdn_w_in, "gdn_conv": gdn_conv, "gdn_a_log": gdn_a_log,
            "gdn_dt_bias": gdn_dt_bias, "gdn_norm_g": gdn_norm_g, "gdn_w_out": gdn_w_out,
            "lru_w_in": lru_w_in, "lru_conv_w": lru_conv_w, "lru_conv_b": lru_conv_b,
            "lru_w_r": lru_w_r, "lru_b_r": lru_b_r, "lru_w_i": lru_w_i, "lru_b_i": lru_b_i,
            "lru_lambda": lru_lambda, "lru_w_out": lru_w_out, "final_g": final_g}


def reference(x, c, ctx, c_ctx, mod_w, mod_b, norm_g, gdn_w_in, gdn_conv, gdn_a_log, gdn_dt_bias,
              gdn_norm_g, gdn_w_out, lru_w_in, lru_conv_w, lru_conv_b, lru_w_r, lru_b_r, lru_w_i, lru_b_i,
              lru_lambda, lru_w_out, final_g):
    rows = x.shape[1] // GRID_W
    sc = jax.nn.silu(c)
    sc_ctx = jax.nn.silu(c_ctx)
    for i in range(DEPTH):
        shift, scale, gate = jnp.split(sc @ mod_w[i] + mod_b[i], 3, axis=-1)
        shift_c, scale_c, gate_c = jnp.split(sc_ctx @ mod_w[i] + mod_b[i], 3, axis=-1)
        h_lat = rmsnorm(x, norm_g[i]) * (1.0 + scale[:, None]) + shift[:, None]
        h_ctx = rmsnorm(ctx, norm_g[i]) * (1.0 + scale_c) + shift_c
        col_major = (i + i // 2) % 2 == 1
        if col_major:
            h_lat = to_col_major(h_lat, rows)
        j = i // 2
        if i % 2 == 0:
            y_ctx, y_lat = gdn_mixer(h_ctx, h_lat, gdn_w_in[j], gdn_conv[j], gdn_a_log[j],
                                     gdn_dt_bias[j], gdn_norm_g[j], gdn_w_out[j])
        else:
            y_ctx, y_lat = rglru_mixer(h_ctx, h_lat, lru_w_in[j], lru_conv_w[j], lru_conv_b[j],
                                       lru_w_r[j], lru_b_r[j], lru_w_i[j], lru_b_i[j],
                                       lru_lambda[j], lru_w_out[j])
        if col_major:
            y_lat = from_col_major(y_lat, rows)
        x = x + gate[:, None] * y_lat
        if i < DEPTH - 1:
            ctx = ctx + gate_c * y_ctx
    return rmsnorm(x, final_g)
```

```cpp
#include <hip/hip_runtime.h>
#include <hip/hip_cooperative_groups.h>
#include <stdint.h>
#include <cstdio>
namespace cg = cooperative_groups;

typedef unsigned short bfu;
using bf16x8 = __attribute__((ext_vector_type(8))) short;
using f32x4 = __attribute__((ext_vector_type(4))) float;

#define DI __device__ __forceinline__
constexpr int NTHR = 512;
constexpr int D = 1024, SEQ = 8192, CTX = 256, TPB = 8448, M = 16896;
constexpr int NCH = 132;

DI int opaque_tid() { int t = threadIdx.x; asm volatile("" : "+v"(t)); return t; }
DI int opaque_bid() { int b = blockIdx.x; asm volatile("" : "+s"(b)); return b; }

#define XB_TMO      128
#define XB_XCNT(j)  (256  + 64 * (j))
#define XB_XSUB(j)  (1280 + 64 * (j))
#define XB_XGEN(j)  (2304 + 64 * (j))
#define XB_TOP      3328
#define XB_TOPGEN   3392
#define XCD_BAR_WORDS 3456
#define XB_SPIN_CAP (1u << 18)
#define LAS __attribute__((address_space(3)))

__device__ __forceinline__ unsigned xb_ld(unsigned* p)              { return __hip_atomic_load(p, __ATOMIC_RELAXED, __HIP_MEMORY_SCOPE_AGENT); }
__device__ __forceinline__ unsigned xb_add(unsigned* p, unsigned v) { return __hip_atomic_fetch_add(p, v, __ATOMIC_RELAXED, __HIP_MEMORY_SCOPE_AGENT); }
__device__ __forceinline__ unsigned xb_xcc_id() { return (unsigned)__builtin_amdgcn_s_getreg((3 << 11) | 20) & 0xFu; }
#define XB_SPIN(cond, bar) do { unsigned _sp = 0; while (cond) { __builtin_amdgcn_s_sleep(1); \
    if ((++_sp & 255u) == 0u) { if (xb_ld(&(bar)[XB_TMO])) break; if (_sp > XB_SPIN_CAP) { atomicAdd(&(bar)[XB_TMO], 1u); break; } } } } while (0)

struct XcdBarrier {
    unsigned* bar; unsigned x;
    volatile LAS unsigned* st;
};

__device__ __forceinline__ XcdBarrier xcd_barrier_post(unsigned* bar, volatile LAS unsigned* st) {
    XcdBarrier b; b.bar = bar; b.x = xb_xcc_id(); b.st = st;
    if (threadIdx.x == 0) (void)xb_add(&bar[XB_XCNT(b.x)], 1u);
    return b;
}
__device__ __forceinline__ void xcd_barrier_complete(unsigned* bar, unsigned x, unsigned& nloc, unsigned& nx) {
    const unsigned G = gridDim.x * gridDim.y * gridDim.z;
    unsigned sum, cnt, mine, sp = 0u;
    for (;;) {
        sum = 0u; cnt = 0u; mine = 0u;
#pragma unroll
        for (unsigned j = 0; j < 16; ++j) { const unsigned c = xb_ld(&bar[XB_XCNT(j)]); sum += c; cnt += (c > 0u) ? 1u : 0u; mine = (j == x) ? c : mine; }
        if (sum == G) break;
        __builtin_amdgcn_s_sleep(1);
        if ((++sp & 255u) == 0u) { if (xb_ld(&bar[XB_TMO])) break; if (sp > XB_SPIN_CAP) { atomicAdd(&bar[XB_TMO], 1u); break; } }
    }
    nloc = mine > 0u ? mine : 1u; nx = cnt > 0u ? cnt : 1u;
}

__device__ __forceinline__ void xcd_barrier(const XcdBarrier& b) {
    asm volatile("s_waitcnt vmcnt(0)" ::: "memory");
    __syncthreads();
    if (threadIdx.x == 0) {
        unsigned* bar = b.bar;
        __builtin_amdgcn_s_waitcnt(0);
        unsigned nloc = b.st[0], nx = b.st[1];
        if (nloc == 0u) { xcd_barrier_complete(bar, b.x, nloc, nx); b.st[0] = nloc; b.st[1] = nx; }
        const unsigned old = xb_add(&bar[XB_XSUB(b.x)], 1u);
        const unsigned gen = old / nloc;
        if (old + 1u == (gen + 1u) * nloc) {
            __builtin_amdgcn_fence(__ATOMIC_RELEASE, "agent");
            asm volatile("s_waitcnt vmcnt(0)" ::: "memory");
            const unsigned og = xb_add(&bar[XB_TOP], 1u);
            const unsigned tg = og / nx;
            if (og + 1u == (tg + 1u) * nx) xb_add(&bar[XB_TOPGEN], 1u);
            else XB_SPIN(xb_ld(&bar[XB_TOPGEN]) == tg, bar);
            __builtin_amdgcn_fence(__ATOMIC_ACQUIRE, "agent");
            xb_add(&bar[XB_XGEN(b.x)], 1u);
            asm volatile("s_waitcnt vmcnt(0)" ::: "memory");
        } else {
            XB_SPIN(xb_ld(&bar[XB_XGEN(b.x)]) == gen, bar);
            __builtin_amdgcn_fence(__ATOMIC_ACQUIRE, "agent");
            asm volatile("s_waitcnt vmcnt(0)" ::: "memory");
        }
    }
    __syncthreads();
}


__device__ __forceinline__ void xcd_barrier_exec(const XcdBarrier& b) {
    asm volatile("s_waitcnt vmcnt(0)" ::: "memory");
    __syncthreads();
    if (threadIdx.x == 0) {
        unsigned* bar = b.bar;
        __builtin_amdgcn_s_waitcnt(0);
        unsigned nloc = b.st[0], nx = b.st[1];
        if (nloc == 0u) { xcd_barrier_complete(bar, b.x, nloc, nx); b.st[0] = nloc; b.st[1] = nx; }
        const unsigned old = xb_add(&bar[XB_XSUB(b.x)], 1u);
        const unsigned gen = old / nloc;
        if (old + 1u == (gen + 1u) * nloc) {
            asm volatile("s_waitcnt vmcnt(0)" ::: "memory");
            const unsigned og = xb_add(&bar[XB_TOP], 1u);
            const unsigned tg = og / nx;
            if (og + 1u == (tg + 1u) * nx) xb_add(&bar[XB_TOPGEN], 1u);
            else XB_SPIN(xb_ld(&bar[XB_TOPGEN]) == tg, bar);
            xb_add(&bar[XB_XGEN(b.x)], 1u);
            asm volatile("s_waitcnt vmcnt(0)" ::: "memory");
        } else {
            XB_SPIN(xb_ld(&bar[XB_XGEN(b.x)]) == gen, bar);
            asm volatile("s_waitcnt vmcnt(0)" ::: "memory");
        }
    }
    __syncthreads();
}


constexpr size_t OFF_BAR = 268435456 - 16384;
DI void light_barrier(unsigned* cnt, unsigned target) {
  asm volatile("s_waitcnt vmcnt(0)" ::: "memory");
  __syncthreads();
  if (threadIdx.x == 0) {
    xb_add(cnt, 1u);
    unsigned sp = 0;
    while (xb_ld(cnt) < target) { __builtin_amdgcn_s_sleep(1); if (++sp > (1u << 22)) break; }
  }
  __syncthreads();
}
typedef __attribute__((ext_vector_type(2))) float f32x2_t;
typedef __attribute__((ext_vector_type(2))) __bf16 bf16x2_t;
DI uint32_t pack2(float a, float b) { f32x2_t v = {a, b}; return __builtin_bit_cast(uint32_t, __builtin_convertvector(v, bf16x2_t)); }
DI bfu f2bf(float x) { return (bfu)(pack2(x, x) & 0xffffu); }
DI float bf2f(bfu x) { return __uint_as_float(((uint32_t)x) << 16); }
DI float sigmoid_f(float x) { return __builtin_amdgcn_rcpf(1.f + __expf(-x)); }
DI float silu_f(float x) { return x * sigmoid_f(x); }
DI float one_minus_exp(float y) { return y > -0.03f ? -y * (1.f + y * (0.5f + y * 0.16666667f)) : 1.f - __expf(y); }
DI float softplus_f(float x) { return x > 20.f ? x : log1pf(__expf(x)); }
DI float wave_sum(float v) {
#pragma unroll
  for (int o = 32; o >= 1; o >>= 1) v += __shfl_xor(v, o);
  return v;
}

struct Params {
  const float *x, *c, *ctx, *c_ctx, *mod_w, *mod_b, *norm_g, *gdn_w_in, *gdn_conv, *gdn_a_log, *gdn_dt_bias, *gdn_norm_g,
      *gdn_w_out, *lru_w_in, *lru_conv_w, *lru_conv_b, *lru_w_r, *lru_b_r, *lru_w_i, *lru_b_i, *lru_lambda, *lru_w_out, *final_g;
  float* out;
  char* ws;
};

constexpr size_t OFF_MOD = 0;
constexpr size_t OFF_CTXRES = OFF_MOD + 147456;
constexpr size_t OFF_WT = OFF_CTXRES + 2097152;
constexpr size_t OFF_H = OFF_WT + 8650752;
constexpr size_t OFF_L = OFF_H + 34603008;
constexpr size_t OFF_PROJ = OFF_L;
constexpr size_t OFF_HALO = OFF_PROJ + 138412032;
constexpr size_t OFF_O = OFF_HALO + 6488064;
constexpr size_t OFF_OCTX2 = OFF_O + 69206016;
constexpr size_t OFF_GG = OFF_OCTX2 + 2097152;
constexpr size_t OFF_GB = OFF_GG + 2162688;
constexpr size_t END_GDN = OFF_GB + 2162688;
constexpr size_t OFF_XB = OFF_L;
constexpr size_t OFF_SG = OFF_XB + 34603008;
constexpr size_t OFF_LA = OFF_SG + 34603008;
constexpr size_t OFF_BB = OFF_LA + 69206016;
constexpr size_t OFF_CP = OFF_BB + 69206016;
constexpr size_t OFF_CH = OFF_CP + 2162688;
constexpr size_t OFF_CI = OFF_CH + 2162688;
constexpr size_t OFF_SPL = OFF_CI + 2162688;
constexpr size_t END_LRU = OFF_SPL + 8192;
static_assert(END_GDN <= 268435456, "ws overflow gdn");
static_assert(END_LRU <= 268435456, "ws overflow lru");

DI int res_row(int m, bool colmajor) {
  int b = m / TPB, p = m - b * TPB;
  if (p < CTX) return -(b * CTX + p) - 1;
  int s = p - CTX;
  int t = colmajor ? ((s & 127) * 64 + (s >> 7)) : s;
  return b * SEQ + t;
}
DI int chain_row(int b, int dir, int pos) {
  int p = dir == 0 ? pos : (pos < CTX ? (CTX - 1 - pos) : (TPB + CTX - 1 - pos));
  return b * TPB + p;
}

template <class BaseF>
DI void transpose_phase(const float* __restrict__ src, int ld, int K, int nrows, bfu* __restrict__ dst, BaseF basef, char* smem) {
  float* tile = (float*)smem;
  const int tid = opaque_tid();
  const int rt = nrows / 64, kt = K / 64;
  for (int t = opaque_bid(); t < rt * kt; t += gridDim.x) {
    const int r0 = (t / kt) * 64, k0 = (t % kt) * 64;
    {
      const int rr = tid & 63;
      const long base = basef(r0 + rr);
#pragma unroll
      for (int i = 0; i < 8; ++i) {
        const int kk = i * 8 + (tid >> 6);
        tile[kk * 65 + rr] = base < 0 ? 0.f : src[base + (long)(k0 + kk) * ld];
      }
    }
    __syncthreads();
#pragma unroll
    for (int i = 0; i < 8; ++i) {
      const int e = i * 512 + tid;
      const int rr = e >> 6, kk = e & 63;
      dst[(size_t)(r0 + rr) * K + k0 + kk] = f2bf(tile[kk * 65 + rr]);
    }
    __syncthreads();
  }
}

template <class Epi, class KOff>
DI void gemm_phase(const bfu* __restrict__ A, int lda, const bfu* __restrict__ Bt, int ldb, int K, int Mt, int Nt, KOff koff,
                   Epi epi, char* smem, bool gdnmap = false) {
  bfu* As = (bfu*)smem;
  bfu* Bs = As + 2 * 256 * 72;
  const int ntiles = Mt * Nt;
  const int nk = K / 64;
  int tile = opaque_bid();
  if (tile >= ntiles) return;
  const int tid = opaque_tid(), lane = tid & 63, wid = tid >> 6;
  const int wm = wid >> 1, wn = wid & 1;
  const int r16 = lane & 15, quad = lane >> 4;
  const int arow = tid >> 3, akq = tid & 7;
  uint4 p0, p1, p2, p3, p4, p5, q0, q1, q2, q3, q4, q5;
#define G_LOAD(x0, x1, x2, x3, x4, x5, kt_) do { const bfu* ap_ = ag + (kt_) * 64; const bfu* bp_ = bg + (kt_) * 64; \
      x0 = *(const uint4*)(ap_); x1 = *(const uint4*)(ap_ + (size_t)64 * lda); x2 = *(const uint4*)(ap_ + (size_t)128 * lda); x3 = *(const uint4*)(ap_ + (size_t)192 * lda); \
      x4 = *(const uint4*)(bp_); x5 = *(const uint4*)(bp_ + (size_t)64 * ldb); } while (0)
#define G_STORE(x0, x1, x2, x3, x4, x5, buf_) do { bfu* as_ = As + ((buf_) * 256 + arow) * 72 + akq * 8; bfu* bs_ = Bs + ((buf_) * 128 + arow) * 72 + akq * 8; \
      *(uint4*)(as_) = x0; *(uint4*)(as_ + 64 * 72) = x1; *(uint4*)(as_ + 128 * 72) = x2; *(uint4*)(as_ + 192 * 72) = x3; \
      *(uint4*)(bs_) = x4; *(uint4*)(bs_ + 64 * 72) = x5; } while (0)
#define R0 p0, p1, p2, p3, p4, p5
#define R1 q0, q1, q2, q3, q4, q5
#define G_LOADR(R, kt_) G_LOAD(R, kt_)
#define G_STORER(R, buf_) G_STORE(R, buf_)
#define G_COMPUTE(buf_) do { _Pragma("unroll") for (int ks_ = 0; ks_ < 2; ++ks_) { bf16x8 af[4], bfr[4]; \
      _Pragma("unroll") for (int i = 0; i < 4; ++i) af[i] = *(const bf16x8*)(As + ((buf_) * 256 + wm * 64 + i * 16 + r16) * 72 + ks_ * 32 + quad * 8); \
      _Pragma("unroll") for (int j = 0; j < 4; ++j) bfr[j] = *(const bf16x8*)(Bs + ((buf_) * 128 + wn * 64 + j * 16 + r16) * 72 + ks_ * 32 + quad * 8); \
      _Pragma("unroll") for (int i = 0; i < 4; ++i) _Pragma("unroll") for (int j = 0; j < 4; ++j) \
        acc[i][j] = __builtin_amdgcn_mfma_f32_16x16x32_bf16(af[i], bfr[j], acc[i][j], 0, 0, 0); } } while (0)
  int mt = tile / Nt, nt = tile - mt * Nt;
#define M_BASE(mt_) (gdnmap ? (((mt_) / 34) * TPB + (((mt_) % 34) == 0 ? 0 : 254 + 253 * (((mt_) % 34) - 1))) : (mt_) * 256)
  const bfu* ag = A + (size_t)(M_BASE(mt) + arow) * lda + koff(nt) + akq * 8;
  const bfu* bg = Bt + (size_t)(nt * 128 + arow) * ldb + akq * 8;
  G_LOADR(R0, 0);
  G_LOADR(R1, 1);
  if (__builtin_amdgcn_readfirstlane(tid) >= 256) __builtin_amdgcn_s_setprio(1);
  for (;;) {
    const int cm0 = M_BASE(mt), cn0 = nt * 128, cnt = nt;
    f32x4 acc[4][4];
#pragma unroll
    for (int i = 0; i < 4; ++i)
#pragma unroll
      for (int j = 0; j < 4; ++j) acc[i][j] = f32x4{0.f, 0.f, 0.f, 0.f};
    G_STORER(R0, 0);
    p0 = q0; p1 = q1; p2 = q2; p3 = q3; p4 = q4; p5 = q5;
    G_LOADR(R1, 2);
    __syncthreads();
    for (int kt = 0; kt < nk; kt += 2) {
      G_STORER(R0, 1);
      if (kt + 3 < nk) G_LOADR(R0, kt + 3);
      G_COMPUTE(0);
      __syncthreads();
      if (kt + 2 < nk) G_STORER(R1, 0);
      if (kt + 4 < nk) G_LOADR(R1, kt + 4);
      G_COMPUTE(1);
      __syncthreads();
    }
    tile += gridDim.x;
    const bool more = tile < ntiles;
    if (more) {
      mt = tile / Nt; nt = tile - mt * Nt;
      ag = A + (size_t)(M_BASE(mt) + arow) * lda + koff(nt) + akq * 8;
      bg = Bt + (size_t)(nt * 128 + arow) * ldb + akq * 8;
      G_LOADR(R0, 0);
      G_LOADR(R1, 1);
    }
    float* Cs = (float*)smem;
#pragma unroll
    for (int i = 0; i < 4; ++i)
#pragma unroll
      for (int j = 0; j < 4; ++j)
#pragma unroll
        for (int e = 0; e < 4; ++e) Cs[(wm * 64 + i * 16 + quad * 4 + e) * 132 + wn * 64 + j * 16 + r16] = acc[i][j][e];
    __syncthreads();
    epi(cm0, cn0, cnt, Cs, tid);
    __syncthreads();
    if (!more) break;
  }
  __builtin_amdgcn_s_setprio(0);
#undef G_LOAD
#undef G_STORE
#undef G_LOADR
#undef G_STORER
#undef R0
#undef R1
#undef G_COMPUTE
#undef M_BASE
}

struct KOffZero { DI int operator()(int) const { return 0; } };
struct KOffLruGate { DI int operator()(int nt) const { return (nt >> 3) * 256; } };

DI void ld8(const float* Cs, int row, int col8, float (&v)[8]) {
  const float4 a = *(const float4*)(Cs + row * 132 + col8), b = *(const float4*)(Cs + row * 132 + col8 + 4);
  v[0] = a.x; v[1] = a.y; v[2] = a.z; v[3] = a.w; v[4] = b.x; v[5] = b.y; v[6] = b.z; v[7] = b.w;
}
DI uint4 pack8(const float (&v)[8]) { uint4 o = {pack2(v[0], v[1]), pack2(v[2], v[3]), pack2(v[4], v[5]), pack2(v[6], v[7])}; return o; }
DI void unpack8(const uint4 u, float (&v)[8]) {
  v[0] = __uint_as_float(u.x << 16); v[1] = __uint_as_float(u.x & 0xffff0000u); v[2] = __uint_as_float(u.y << 16); v[3] = __uint_as_float(u.y & 0xffff0000u);
  v[4] = __uint_as_float(u.z << 16); v[5] = __uint_as_float(u.z & 0xffff0000u); v[6] = __uint_as_float(u.w << 16); v[7] = __uint_as_float(u.w & 0xffff0000u);
}

struct EpiGdn1 {
  bfu* proj; bfu* halo; float* ab;
  DI void operator()(int m0, int n0, int nt, const float* Cs, int tid) const {
    if (nt < 32) {
#pragma unroll
      for (int k = 0; k < 8; ++k) {
        const int c = tid + 512 * k, row = c >> 4, col8 = (c & 15) * 8;
        float v[8]; ld8(Cs, row, col8, v);
        const uint4 pv = pack8(v);
        const int m = m0 + row, n = n0 + col8;
        *(uint4*)(proj + (size_t)m * 4096 + n) = pv;
        const int r = m & 63, T = m >> 6;
        if (r >= 62 && T + 1 < 264) *(uint4*)(halo + ((size_t)(T + 1) * 3 + (r - 62)) * 4096 + n) = pv;
        if (r == 0 && T >= 1) *(uint4*)(halo + ((size_t)(T - 1) * 3 + 2) * 4096 + n) = pv;
      }
    } else {
#pragma unroll
      for (int k = 0; k < 4; ++k) {
        const int c = tid + 512 * k, row = c >> 3, col8 = (c & 7) * 8;
        float v[8]; ld8(Cs, row, col8, v);
        float* dst = ab + (size_t)(m0 + row) * 64 + col8;
        *(float4*)dst = float4{v[0], v[1], v[2], v[3]};
        *(float4*)(dst + 4) = float4{v[4], v[5], v[6], v[7]};
      }
    }
  }
};

struct EpiGdn1Conv {
  bfu* proj; float* ab; const float* cw;
  DI void operator()(int m0, int n0, int nt, const float* Cs, int tid) const {
    const int b = m0 / TPB, p0 = m0 - b * TPB;
    int vlo, vhi, olo, ohi;
    if (p0 == 0) { vlo = 0; vhi = 256; olo = 0; ohi = 256; }
    else { const int s0 = p0 - CTX; vlo = s0 < 0 ? -s0 : 0; vhi = SEQ - s0 < 256 ? SEQ - s0 : 256; olo = 2; ohi = vhi < 255 ? vhi : 255; }
    if (nt < 32) {
      const int col8 = (tid & 15) * 8, n = n0 + col8;
      float w[4][8];
#pragma unroll
      for (int j = 0; j < 4; ++j) {
        const float4 w0 = *(const float4*)(cw + j * 4096 + n), w1 = *(const float4*)(cw + j * 4096 + n + 4);
        w[j][0] = w0.x; w[j][1] = w0.y; w[j][2] = w0.z; w[j][3] = w0.w; w[j][4] = w1.x; w[j][5] = w1.y; w[j][6] = w1.z; w[j][7] = w1.w;
      }
#pragma unroll
      for (int k = 0; k < 8; ++k) {
        const int row = (tid >> 4) + 32 * k;
        float y[8];
#pragma unroll
        for (int e = 0; e < 8; ++e) y[e] = 0.f;
#pragma unroll
        for (int j = 0; j < 4; ++j) {
          const int rr = row - 2 + j;
          if (rr >= vlo && rr < vhi) {
            float x[8]; ld8(Cs, rr, col8, x);
#pragma unroll
            for (int e = 0; e < 8; ++e) y[e] += w[j][e] * x[e];
          }
        }
        float ss = 0.f;
#pragma unroll
        for (int e = 0; e < 8; ++e) { y[e] = silu_f(y[e]); ss += y[e] * y[e]; }
        if (n0 < 2048) {
#pragma unroll
          for (int off = 8; off >= 1; off >>= 1) ss += __shfl_xor(ss, off);
          float sc = rsqrtf(ss + 1e-6f);
          if (n0 < 1024) sc *= 0.08838834764831845f;
#pragma unroll
          for (int e = 0; e < 8; ++e) y[e] *= sc;
        }
        if (row >= olo && row < ohi) *(uint4*)(proj + (size_t)(m0 + row) * 4096 + n) = pack8(y);
      }
    } else {
#pragma unroll
      for (int k = 0; k < 4; ++k) {
        const int c = tid + 512 * k, row = c >> 3, col8 = (c & 7) * 8;
        if (row >= olo && row < ohi) {
          float v[8]; ld8(Cs, row, col8, v);
          float* dst = ab + (size_t)(m0 + row) * 64 + col8;
          *(float4*)dst = float4{v[0], v[1], v[2], v[3]};
          *(float4*)(dst + 4) = float4{v[4], v[5], v[6], v[7]};
        }
      }
    }
  }
};

struct EpiZGate {
  bfu* a2; const bfu* octx2; const float* ng;
  DI void operator()(int m0, int n0, int nt, const float* Cs, int tid) const {
#pragma unroll
    for (int k = 0; k < 8; ++k) {
      const int c = tid + 512 * k, row = c >> 4, col8 = (c & 15) * 8;
      float v[8], a[8]; ld8(Cs, row, col8, v);
      const int m = m0 + row;
      bfu* ptr = a2 + (size_t)m * 2048 + n0 + col8;
      unpack8(*(const uint4*)ptr, a);
      const int b = m / TPB, p = m - b * TPB;
      if (p < CTX) {
        float a2v[8];
        unpack8(*(const uint4*)(octx2 + (size_t)(b * CTX + p) * 2048 + n0 + col8), a2v);
#pragma unroll
        for (int e = 0; e < 8; ++e) a[e] += a2v[e];
      }
      float ss = 0.f;
#pragma unroll
      for (int e = 0; e < 8; ++e) ss += a[e] * a[e];
#pragma unroll
      for (int off = 8; off >= 1; off >>= 1) ss += __shfl_xor(ss, off);
      const float rstd = rsqrtf(ss * (1.0f / 128.0f) + 1e-6f);
      const float4 g0 = *(const float4*)(ng + col8), g1 = *(const float4*)(ng + col8 + 4);
      const float gv[8] = {g0.x, g0.y, g0.z, g0.w, g1.x, g1.y, g1.z, g1.w};
#pragma unroll
      for (int e = 0; e < 8; ++e) a[e] = bf2f(f2bf(a[e] * rstd * gv[e])) * silu_f(v[e]);
      *(uint4*)ptr = pack8(a);
    }
  }
};

struct EpiResid {
  const float* xsrc; float* xdst; float* ctxres; const float* modl;
  bool colmajor; bool upd_ctx;
  DI void operator()(int m0, int n0, int nt, const float* Cs, int tid) const {
#pragma unroll
    for (int k = 0; k < 8; ++k) {
      const int c = tid + 512 * k, row = c >> 4, col8 = (c & 15) * 8;
      float v[8]; ld8(Cs, row, col8, v);
      const int rr = res_row(m0 + row, colmajor);
      const int n = n0 + col8;
      const float* src; float* dst; int vsel;
      if (rr >= 0) { src = xsrc + (size_t)rr * 1024 + n; dst = xdst + (size_t)rr * 1024 + n; vsel = rr >> 13; }
      else { src = ctxres + (size_t)(-rr - 1) * 1024 + n; dst = ctxres + (size_t)(-rr - 1) * 1024 + n; vsel = 2; }
      if (rr >= 0 || upd_ctx) {
        const float* gp = modl + vsel * 3072 + 2048 + n;
        const float4 g0 = *(const float4*)gp, g1 = *(const float4*)(gp + 4);
        const float4 x0 = *(const float4*)src, x1 = *(const float4*)(src + 4);
        *(float4*)dst = float4{x0.x + g0.x * v[0], x0.y + g0.y * v[1], x0.z + g0.z * v[2], x0.w + g0.w * v[3]};
        *(float4*)(dst + 4) = float4{x1.x + g1.x * v[4], x1.y + g1.y * v[5], x1.z + g1.z * v[6], x1.w + g1.w * v[7]};
      }
    }
  }
};

struct EpiLruIn {
  bfu* xb; bfu* sg;
  DI void operator()(int m0, int n0, int nt, const float* Cs, int tid) const {
#pragma unroll
    for (int k = 0; k < 8; ++k) {
      const int c = tid + 512 * k, row = c >> 4, col8 = (c & 15) * 8;
      float v[8]; ld8(Cs, row, col8, v);
      const int n = n0 + col8;
      if (n < 1024) *(uint4*)(xb + (size_t)(m0 + row) * 1024 + n) = pack8(v);
      else {
#pragma unroll
        for (int e = 0; e < 8; ++e) v[e] = silu_f(v[e]);
        *(uint4*)(sg + (size_t)(m0 + row) * 1024 + n - 1024) = pack8(v);
      }
    }
  }
};

struct EpiLruInConv {
  bfu* xc; bfu* sg; const float* cw; const float* cb;
  DI void operator()(int m0, int n0, int nt, const float* Cs, int tid) const {
    const int b = m0 / TPB, p0 = m0 - b * TPB;
    int vlo, vhi, olo, ohi;
    if (p0 == 0) { vlo = 0; vhi = 256; olo = 0; ohi = 256; }
    else { const int s0 = p0 - CTX; vlo = s0 < 0 ? -s0 : 0; vhi = SEQ - s0 < 256 ? SEQ - s0 : 256; olo = 2; ohi = vhi < 255 ? vhi : 255; }
    const int col8 = (tid & 15) * 8, n = n0 + col8;
    if (n0 < 1024) {
      float w[4][8], bias[8];
#pragma unroll
      for (int j = 0; j < 4; ++j) {
        const float4 w0 = *(const float4*)(cw + j * 1024 + n), w1 = *(const float4*)(cw + j * 1024 + n + 4);
        w[j][0] = w0.x; w[j][1] = w0.y; w[j][2] = w0.z; w[j][3] = w0.w; w[j][4] = w1.x; w[j][5] = w1.y; w[j][6] = w1.z; w[j][7] = w1.w;
      }
      {
        const float4 b0 = *(const float4*)(cb + n), b1 = *(const float4*)(cb + n + 4);
        bias[0] = b0.x; bias[1] = b0.y; bias[2] = b0.z; bias[3] = b0.w; bias[4] = b1.x; bias[5] = b1.y; bias[6] = b1.z; bias[7] = b1.w;
      }
#pragma unroll
      for (int k = 0; k < 8; ++k) {
        const int row = (tid >> 4) + 32 * k;
        if (row >= olo && row < ohi) {
          float y[8];
#pragma unroll
          for (int e = 0; e < 8; ++e) y[e] = bias[e];
#pragma unroll
          for (int j = 0; j < 4; ++j) {
            const int rr = row - 2 + j;
            if (rr >= vlo && rr < vhi) {
              float x[8]; ld8(Cs, rr, col8, x);
#pragma unroll
              for (int e = 0; e < 8; ++e) y[e] += w[j][e] * x[e];
            }
          }
          *(uint4*)(xc + (size_t)(m0 + row) * 1024 + n) = pack8(y);
        }
      }
    } else {
#pragma unroll
      for (int k = 0; k < 8; ++k) {
        const int row = (tid >> 4) + 32 * k;
        if (row >= olo && row < ohi) {
          float v[8]; ld8(Cs, row, col8, v);
#pragma unroll
          for (int e = 0; e < 8; ++e) v[e] = silu_f(v[e]);
          *(uint4*)(sg + (size_t)(m0 + row) * 1024 + n - 1024) = pack8(v);
        }
      }
    }
  }
};

struct EpiLruGate {
  const bfu* xc; bfu* la; bfu* bb; const float* b_r; const float* b_i; const float* spl;
  DI void operator()(int m0, int n0, int nt, const float* Cs, int tid) const {
#pragma unroll
    for (int k = 0; k < 4; ++k) {
      const int c = tid + 512 * k, row = c >> 3, g = (c >> 2) & 1, c4 = c & 3;
      const int grp = (n0 >> 6) + g;
      const int cg8 = grp & 7, d = (grp >> 3) & 1, nblk = grp >> 4;
      const int ch = nblk * 256 + cg8 * 32 + c4 * 8;
      float vr[8], vi[8], xv[8];
      ld8(Cs, row, g * 64 + c4 * 8, vr);
      ld8(Cs, row, g * 64 + 32 + c4 * 8, vi);
      const int m = m0 + row;
      unpack8(*(const uint4*)(xc + (size_t)m * 1024 + ch), xv);
      float lo[8], bo[8];
#pragma unroll
      for (int e = 0; e < 8; ++e) {
        const float r = sigmoid_f(vr[e] + b_r[d * 1024 + ch + e]);
        const float ig = sigmoid_f(vi[e] + b_i[d * 1024 + ch + e]);
        const float loga = -8.0f * r * spl[d * 1024 + ch + e];
        lo[e] = loga;
        bo[e] = __builtin_amdgcn_sqrtf(one_minus_exp(2.0f * loga)) * (ig * xv[e]);
      }
      *(uint4*)(la + ((size_t)m * 2 + d) * 1024 + ch) = pack8(lo);
      *(uint4*)(bb + ((size_t)m * 2 + d) * 1024 + ch) = pack8(bo);
    }
  }
};

DI void mod_phase(const Params& p, float* mod, char* smem) {
  float* sc = (float*)smem;
  float* red = sc + 3 * 1024;
  const int tid = opaque_tid(), lane = tid & 63, wid = tid >> 6;
  for (int i = tid; i < 3 * 1024; i += NTHR) {
    const int v = i >> 10, k = i & 1023;
    const float cv = v < 2 ? p.c[v * 1024 + k] : p.c_ctx[k];
    sc[i] = silu_f(cv);
  }
  __syncthreads();
  for (int t = opaque_bid(); t < 192; t += gridDim.x) {
    const int l = t / 48, n = (t % 48) * 64 + lane;
    const float* w = p.mod_w + (size_t)l * 1024 * 3072 + n;
    float a0 = 0.f, a1 = 0.f, a2 = 0.f;
    for (int k0 = wid * 128; k0 < wid * 128 + 128; k0 += 32) {
      float wv[32];
#pragma unroll
      for (int u = 0; u < 32; ++u) wv[u] = w[(size_t)(k0 + u) * 3072];
#pragma unroll
      for (int u = 0; u < 32; ++u) { a0 += sc[k0 + u] * wv[u]; a1 += sc[1024 + k0 + u] * wv[u]; a2 += sc[2048 + k0 + u] * wv[u]; }
    }
    red[(wid * 3 + 0) * 64 + lane] = a0; red[(wid * 3 + 1) * 64 + lane] = a1; red[(wid * 3 + 2) * 64 + lane] = a2;
    __syncthreads();
    if (tid < 192) {
      const int v = tid >> 6;
      float s = 0.f;
      for (int w8 = 0; w8 < 8; ++w8) s += red[(w8 * 3 + v) * 64 + lane];
      mod[((size_t)l * 3 + v) * 3072 + n] = s + p.mod_b[l * 3072 + n];
    }
    __syncthreads();
  }
}

DI void norm_phase(const float* xsrc, const float* ctxres, const float* ng, const float* modl, bool colmajor, bfu* h) {
  const int tid = opaque_tid(), lane = tid & 63, wid = tid >> 6;
  const int nw = gridDim.x * 8;
  for (int m0 = opaque_bid() * 8 + wid; m0 < M; m0 += 2 * nw) {
    const float* src[2]; int vv[2]; bool ok[2];
    float4 xv[2][4];
#pragma unroll
    for (int u = 0; u < 2; ++u) {
      const int m = m0 + u * nw;
      ok[u] = m < M;
      const int rr = res_row(ok[u] ? m : m0, colmajor);
      if (rr >= 0) { src[u] = xsrc + (size_t)rr * 1024; vv[u] = rr >> 13; } else { src[u] = ctxres + (size_t)(-rr - 1) * 1024; vv[u] = 2; }
#pragma unroll
      for (int i = 0; i < 4; ++i) xv[u][i] = *(const float4*)(src[u] + i * 256 + lane * 4);
    }
#pragma unroll
    for (int u = 0; u < 2; ++u) {
      float ss = 0.f;
#pragma unroll
      for (int i = 0; i < 4; ++i) ss += xv[u][i].x * xv[u][i].x + xv[u][i].y * xv[u][i].y + xv[u][i].z * xv[u][i].z + xv[u][i].w * xv[u][i].w;
      ss = wave_sum(ss);
      const float rstd = rsqrtf(ss * (1.0f / 1024.0f) + 1e-6f);
      const float* shift = modl + vv[u] * 3072;
      const float* scale = shift + 1024;
      if (ok[u]) {
#pragma unroll
        for (int i = 0; i < 4; ++i) {
          const int k = i * 256 + lane * 4;
          const float4 g = *(const float4*)(ng + k), sc = *(const float4*)(scale + k), sh = *(const float4*)(shift + k);
          uint2 ov = {pack2(xv[u][i].x * rstd * g.x * (1.f + sc.x) + sh.x, xv[u][i].y * rstd * g.y * (1.f + sc.y) + sh.y),
                      pack2(xv[u][i].z * rstd * g.z * (1.f + sc.z) + sh.z, xv[u][i].w * rstd * g.w * (1.f + sc.w) + sh.w)};
          *(uint2*)(h + (size_t)(m0 + u * nw) * 1024 + k) = ov;
        }
      }
    }
  }
}

DI void final_norm_phase(float* x, const float* fg) {
  const int lane = opaque_tid() & 63, wid = opaque_tid() >> 6;
  for (int r = opaque_bid() * 8 + wid; r < 2 * SEQ; r += gridDim.x * 8) {
    float* src = x + (size_t)r * 1024;
    float4 xv[4];
    float ss = 0.f;
#pragma unroll
    for (int i = 0; i < 4; ++i) {
      xv[i] = *(const float4*)(src + i * 256 + lane * 4);
      ss += xv[i].x * xv[i].x + xv[i].y * xv[i].y + xv[i].z * xv[i].z + xv[i].w * xv[i].w;
    }
    ss = wave_sum(ss);
    const float rstd = rsqrtf(ss * (1.0f / 1024.0f) + 1e-6f);
#pragma unroll
    for (int i = 0; i < 4; ++i) {
      const int k = i * 256 + lane * 4;
      const float4 g = *(const float4*)(fg + k);
      float4 o = {xv[i].x * rstd * g.x, xv[i].y * rstd * g.y, xv[i].z * rstd * g.z, xv[i].w * rstd * g.w};
      *(float4*)(src + k) = o;
    }
  }
}

DI void ld2(const bfu* ptr, float& a, float& b) {
  const uint32_t v = *(const uint32_t*)ptr;
  a = __uint_as_float(v << 16);
  b = __uint_as_float(v & 0xffff0000u);
}

DI void gdn_conv_phase(bfu* proj, const bfu* halo, const float* cw) {
  const int lane = opaque_tid() & 63, wid = opaque_tid() >> 6;
  for (int task = opaque_bid() * 8 + wid; task < 264 * 32; task += gridDim.x * 8) {
    const int T = task >> 5, u_ = task & 31;
    const int ch = u_ * 128 + lane * 2;
    const int p0 = (T % NCH) * 64;
    const bool sstart = (p0 == 0 || p0 == CTX), send = (p0 + 64 == CTX || p0 + 64 == TPB);
    float w00 = cw[0 * 4096 + ch], w01 = cw[0 * 4096 + ch + 1];
    float w10 = cw[1 * 4096 + ch], w11 = cw[1 * 4096 + ch + 1];
    float w20 = cw[2 * 4096 + ch], w21 = cw[2 * 4096 + ch + 1];
    float w30 = cw[3 * 4096 + ch], w31 = cw[3 * 4096 + ch + 1];
    float xm2a = 0.f, xm2b = 0.f, xm1a = 0.f, xm1b = 0.f, x0a, x0b, xp1a, xp1b;
    if (!sstart) { ld2(halo + ((size_t)T * 3 + 0) * 4096 + ch, xm2a, xm2b); ld2(halo + ((size_t)T * 3 + 1) * 4096 + ch, xm1a, xm1b); }
    bfu* row = proj + (size_t)T * 64 * 4096 + ch;
    ld2(row, x0a, x0b);
    for (int t8 = 0; t8 < 64; t8 += 16) {
      uint32_t nx[16];
#pragma unroll
      for (int u = 0; u < 16; ++u) {
        const int tt = t8 + u;
        if (tt < 63) nx[u] = *(const uint32_t*)(row + (size_t)(tt + 1) * 4096);
        else nx[u] = send ? 0u : *(const uint32_t*)(halo + ((size_t)T * 3 + 2) * 4096 + ch);
      }
#pragma unroll
      for (int u = 0; u < 16; ++u) {
        const int tt = t8 + u;
        xp1a = __uint_as_float(nx[u] << 16); xp1b = __uint_as_float(nx[u] & 0xffff0000u);
        float y0 = w00 * xm2a + w10 * xm1a + w20 * x0a + w30 * xp1a;
        float y1 = w01 * xm2b + w11 * xm1b + w21 * x0b + w31 * xp1b;
        y0 = silu_f(y0); y1 = silu_f(y1);
        if (u_ < 16) {
          const float ss = wave_sum(y0 * y0 + y1 * y1);
          float sc = rsqrtf(ss + 1e-6f);
          if (u_ < 8) sc *= 0.08838834764831845f;
          y0 *= sc; y1 *= sc;
        }
        *(uint32_t*)(row + (size_t)tt * 4096) = pack2(y0, y1);
        xm2a = xm1a; xm2b = xm1b; xm1a = x0a; xm1b = x0b; x0a = xp1a; x0b = xp1b;
      }
    }
  }
}

using f32x16 = __attribute__((ext_vector_type(16))) float;
#define MFMA32(a, b, c) __builtin_amdgcn_mfma_f32_32x32x16_bf16((a), (b), (c), 0, 0, 0)
constexpr int SEG_STRIDE = 28800;
constexpr int WF_OFF = 0, KDF_OFF = 8192, QKF_OFF = 16384, UF_OFF = 20480, EG_OFF = 28672;
constexpr int SEG_STEPS = 8;
constexpr int PREP_HALF_LDS = 75776;

DI bf16x8 frag8(const bfu* p) {
  const uint2 a = *(const uint2*)p, b = *(const uint2*)(p + 4);
  uint4 v = {a.x, a.y, b.x, b.y};
  return __builtin_bit_cast(bf16x8, v);
}
DI int crow(int i, int h) { return (i & 3) + 8 * (i >> 2) + 4 * h; }

DI void gdn_prep(const bfu* __restrict__ proj, const float* __restrict__ gab, const float* __restrict__ a_log,
                 const float* __restrict__ dt_bias, bfu* __restrict__ seg, float* __restrict__ glbuf, int s0, int s1, char* smem,
                 unsigned* prog, unsigned need) {
  const int ntasks = 64 * (s1 - s0);
  for (int pt = opaque_bid(); pt * 2 < ntasks; pt += gridDim.x) {
    const int tid = opaque_tid(), half = tid >> 8, ht = tid & 255, hw = ht >> 6, lane = tid & 63;
    const int r = lane & 31, h = lane >> 5;
    char* base = smem + half * PREP_HALF_LDS;
    bfu* qs = (bfu*)base;
    bfu* ks = qs + 64 * 136;
    bfu* kT = ks + 64 * 136;
    bfu* vT = kT + 128 * 68;
    float* gs = (float*)(vT + 128 * 68);
    float* Lm = (float*)qs;
    bfu* T1 = ks;
    bfu* T2 = ks + 64 * 68;
    const int tsk0 = pt * 2 + half;
    const bool valid = tsk0 < ntasks;
    const int tsk = valid ? tsk0 : ntasks - 1;
    const int slot = tsk >> 6, chain = tsk & 63, step = s0 + slot;
    const int b = chain >> 5, dir = (chain >> 4) & 1, hh = chain & 15, qh = hh >> 1;
    const int m0 = chain_row(b, dir, step * 64);
    const int sgn = dir == 0 ? 1 : -1;
    bfu* segp = seg + ((size_t)slot * 64 + chain) * SEG_STRIDE;
    if (need != 0u) {
      if (ht == 0) { unsigned sp = 0; while (xb_ld(prog + 8 * chain) < need) { __builtin_amdgcn_s_sleep(1); if (++sp > (1u << 20)) break; } }
      __syncthreads();
    }
    if (hw == 0) {
      const int m = m0 + sgn * lane;
      const float rawg = gab[(size_t)m * 64 + dir * 32 + hh], rawb = gab[(size_t)m * 64 + dir * 32 + 16 + hh];
      const float g = -__expf(a_log[dir * 16 + hh]) * softplus_f(rawg + dt_bias[dir * 16 + hh]);
      float cs = g;
#pragma unroll
      for (int o = 1; o < 64; o <<= 1) { const float t = __shfl_up(cs, o); if (lane >= o) cs += t; }
      const float gl = __shfl(cs, 63);
      gs[lane] = cs; gs[64 + lane] = sigmoid_f(rawb); gs[128 + lane] = __expf(cs); gs[192 + lane] = __expf(gl - cs);
      if (lane == 0 && valid) glbuf[chain * NCH + step] = __expf(gl);
      if (valid) ((float*)(segp + EG_OFF))[lane] = __expf(cs);
    }
#pragma unroll
    for (int it = 0; it < 4; ++it) {
      const int c = (ht & 15) + 16 * hw, col8 = (((ht >> 4) & 3) + 4 * it) * 8;
      const bfu* rowp = proj + (size_t)(m0 + sgn * c) * 4096;
      const uint4 qv = *(const uint4*)(rowp + qh * 128 + col8);
      const uint4 kv = *(const uint4*)(rowp + 1024 + qh * 128 + col8);
      const uint4 vv = *(const uint4*)(rowp + 2048 + hh * 128 + col8);
      *(uint4*)(qs + c * 136 + col8) = qv;
      *(uint4*)(ks + c * 136 + col8) = kv;
      const uint32_t kw[4] = {kv.x, kv.y, kv.z, kv.w}, vw[4] = {vv.x, vv.y, vv.z, vv.w};
#pragma unroll
      for (int i = 0; i < 4; ++i) {
        kT[(col8 + 2 * i) * 68 + c] = (bfu)(kw[i] & 0xffffu);
        kT[(col8 + 2 * i + 1) * 68 + c] = (bfu)(kw[i] >> 16);
        vT[(col8 + 2 * i) * 68 + c] = (bfu)(vw[i] & 0xffffu);
        vT[(col8 + 2 * i + 1) * 68 + c] = (bfu)(vw[i] >> 16);
      }
    }
    __syncthreads();
    const int ti = hw >> 1, tj = hw & 1;
    f32x16 kkacc, qkacc;
#pragma unroll
    for (int i = 0; i < 16; ++i) { kkacc[i] = 0.f; qkacc[i] = 0.f; }
#pragma unroll
    for (int k8 = 0; k8 < 8; ++k8) {
      const bf16x8 a = *(const bf16x8*)(ks + (32 * ti + r) * 136 + 16 * k8 + 8 * h);
      const bf16x8 bk = *(const bf16x8*)(ks + (32 * tj + r) * 136 + 16 * k8 + 8 * h);
      const bf16x8 bq = *(const bf16x8*)(qs + (32 * tj + r) * 136 + 16 * k8 + 8 * h);
      kkacc = MFMA32(a, bk, kkacc);
      qkacc = MFMA32(a, bq, qkacc);
    }
    __syncthreads();
#pragma unroll
    for (int i = 0; i < 16; ++i) {
      const int c = 32 * ti + crow(i, h), sidx = 32 * tj + r;
      Lm[c * 64 + sidx] = (sidx < c) ? gs[64 + c] * kkacc[i] * __expf(gs[c] - gs[sidx]) : 0.f;
    }
#pragma unroll
    for (int q = 0; q < 4; ++q) {
      const int c = 32 * tj + r;
      float vals[4];
#pragma unroll
      for (int t = 0; t < 4; ++t) {
        const int sidx = 32 * ti + 8 * q + 4 * h + t;
        vals[t] = (sidx <= c) ? qkacc[4 * q + t] * __expf(gs[c] - gs[sidx]) : 0.f;
      }
      const int k4 = 2 * ti + (q >> 1), hp = q & 1;
      uint2 ov = {pack2(vals[0], vals[1]), pack2(vals[2], vals[3])};
      if (valid) *(uint2*)(segp + QKF_OFF + ((tj * 4 + k4) * 64 + hp * 32 + r) * 8 + 4 * h) = ov;
    }
    __syncthreads();
    bfu* TB = (bfu*)(gs + 256);
    bfu* TA = TB + 32 * 40;
    const int wa = half, wb = half ^ 1;
    if (hw == wa || hw == wb) {
      const int ob = (hw == wa) ? 0 : 32;
      f32x2_t t2[16];
#pragma unroll
      for (int i = 0; i < 16; ++i) t2[i] = f32x2_t{0.f, 0.f};
      int r_o = r;
      asm volatile("" : "+v"(r_o));
#pragma unroll
      for (int i = 0; i < 32; ++i) {
        f32x2_t a0 = {0.f, 0.f}, a1 = {0.f, 0.f};
#pragma unroll
        for (int q = 0; q < (i + 3) / 4; ++q) {
          const float4 l4 = *(const float4*)(Lm + (ob + i) * 64 + ob + 4 * q);
          a0 = __builtin_elementwise_fma(f32x2_t{l4.x, l4.y}, t2[2 * q], a0);
          a1 = __builtin_elementwise_fma(f32x2_t{l4.z, l4.w}, t2[2 * q + 1], a1);
        }
        const float acc = ((i == r_o) ? 1.f : 0.f) - ((a0[0] + a0[1]) + (a1[0] + a1[1]));
        t2[i >> 1][i & 1] = acc;
        if ((i & 15) == 15) __builtin_amdgcn_sched_barrier(0);
      }
      const float s2 = gs[64 + ob + r], s1v = s2 * gs[128 + ob + r];
      if (h == 0) {
#pragma unroll
        for (int i = 0; i < 32; ++i) {
          const uint32_t pk = pack2(t2[i >> 1][i & 1] * s1v, t2[i >> 1][i & 1] * s2);
          T1[(ob + i) * 68 + ob + r] = (bfu)(pk & 0xffffu);
          T2[(ob + i) * 68 + ob + r] = (bfu)(pk >> 16);
        }
      } else if (hw == wa) {
#pragma unroll
        for (int g = 0; g < 4; ++g) {
          uint4 v = {pack2(t2[4 * g][0], t2[4 * g][1]), pack2(t2[4 * g + 1][0], t2[4 * g + 1][1]),
                     pack2(t2[4 * g + 2][0], t2[4 * g + 2][1]), pack2(t2[4 * g + 3][0], t2[4 * g + 3][1])};
          *(uint4*)(TB + r * 40 + 8 * g) = v;
        }
      } else {
#pragma unroll
        for (int i = 0; i < 32; ++i) {
          TA[i * 40 + r] = f2bf(t2[i >> 1][i & 1]);
          T1[i * 68 + 32 + r] = 0;
          T2[i * 68 + 32 + r] = 0;
        }
      }
    } else {
      for (int idx = (hw - 2) * 64 + lane; idx < 1024; idx += 128) {
        const int l_ = idx & 63, k4 = (idx >> 6) & 3, dkb = idx >> 8;
        const int dk = 32 * dkb + (l_ & 31), cb = 16 * k4 + 8 * (l_ >> 5);
        const uint2 v0 = *(const uint2*)(kT + dk * 68 + cb), v1 = *(const uint2*)(kT + dk * 68 + cb + 4);
        const float* ek = gs + 192 + cb;
        uint4 ov;
        ov.x = pack2(__uint_as_float(v0.x << 16) * ek[0], __uint_as_float(v0.x & 0xffff0000u) * ek[1]);
        ov.y = pack2(__uint_as_float(v0.y << 16) * ek[2], __uint_as_float(v0.y & 0xffff0000u) * ek[3]);
        ov.z = pack2(__uint_as_float(v1.x << 16) * ek[4], __uint_as_float(v1.x & 0xffff0000u) * ek[5]);
        ov.w = pack2(__uint_as_float(v1.y << 16) * ek[6], __uint_as_float(v1.y & 0xffff0000u) * ek[7]);
        if (valid) *(uint4*)(segp + KDF_OFF + idx * 8) = ov;
      }
    }
    __syncthreads();
    if (hw == wa) {
      f32x16 X, Y;
#pragma unroll
      for (int i = 0; i < 16; ++i) { X[i] = 0.f; Y[i] = 0.f; }
#pragma unroll
      for (int k2 = 0; k2 < 2; ++k2) {
        const float4 l0 = *(const float4*)(Lm + (32 + r) * 64 + 16 * k2 + 8 * h), l1 = *(const float4*)(Lm + (32 + r) * 64 + 16 * k2 + 8 * h + 4);
        const uint4 av = {pack2(l0.x, l0.y), pack2(l0.z, l0.w), pack2(l1.x, l1.y), pack2(l1.z, l1.w)};
        const bf16x8 bt = *(const bf16x8*)(TB + r * 40 + 16 * k2 + 8 * h);
        X = MFMA32(__builtin_bit_cast(bf16x8, av), bt, X);
      }
#pragma unroll
      for (int s2i = 0; s2i < 2; ++s2i) {
        const uint4 xv = {pack2(X[8 * s2i], X[8 * s2i + 1]), pack2(X[8 * s2i + 2], X[8 * s2i + 3]),
                          pack2(X[8 * s2i + 4], X[8 * s2i + 5]), pack2(X[8 * s2i + 6], X[8 * s2i + 7])};
        const uint2 a_lo = *(const uint2*)(TA + r * 40 + 16 * s2i + 4 * h), a_hi = *(const uint2*)(TA + r * 40 + 16 * s2i + 8 + 4 * h);
        const uint4 av = {a_lo.x, a_lo.y, a_hi.x, a_hi.y};
        Y = MFMA32(__builtin_bit_cast(bf16x8, av), __builtin_bit_cast(bf16x8, xv), Y);
      }
      const float c2 = gs[64 + r], c1 = c2 * gs[128 + r];
#pragma unroll
      for (int i = 0; i < 16; ++i) {
        const uint32_t pk = pack2(-Y[i] * c1, -Y[i] * c2);
        T1[(32 + crow(i, h)) * 68 + r] = (bfu)(pk & 0xffffu);
        T2[(32 + crow(i, h)) * 68 + r] = (bfu)(pk >> 16);
      }
    }
    __syncthreads();
    {
      f32x16 wa0, wa1;
#pragma unroll
      for (int i = 0; i < 16; ++i) { wa0[i] = 0.f; wa1[i] = 0.f; }
#pragma unroll
      for (int k4 = 0; k4 < 4; ++k4) {
        const int ko = 16 * k4 + 8 * h;
        const bf16x8 ak = frag8(kT + (32 * hw + r) * 68 + ko);
        const bf16x8 bt0 = frag8(T1 + r * 68 + ko), bt1 = frag8(T1 + (32 + r) * 68 + ko);
        wa0 = MFMA32(ak, bt0, wa0);
        wa1 = MFMA32(ak, bt1, wa1);
      }
      if (valid) {
#pragma unroll
        for (int q = 0; q < 4; ++q) {
          const int k8 = 2 * hw + (q >> 1), hp = q & 1;
          uint2 o0 = {pack2(-wa0[4 * q], -wa0[4 * q + 1]), pack2(-wa0[4 * q + 2], -wa0[4 * q + 3])};
          uint2 o1 = {pack2(-wa1[4 * q], -wa1[4 * q + 1]), pack2(-wa1[4 * q + 2], -wa1[4 * q + 3])};
          *(uint2*)(segp + WF_OFF + ((0 * 8 + k8) * 64 + hp * 32 + r) * 8 + 4 * h) = o0;
          *(uint2*)(segp + WF_OFF + ((1 * 8 + k8) * 64 + hp * 32 + r) * 8 + 4 * h) = o1;
        }
      }
    }
    {
      f32x16 ua0, ua1;
#pragma unroll
      for (int i = 0; i < 16; ++i) { ua0[i] = 0.f; ua1[i] = 0.f; }
#pragma unroll
      for (int k4 = 0; k4 < 4; ++k4) {
        const int ko = 16 * k4 + 8 * h;
        const bf16x8 at0 = frag8(T2 + r * 68 + ko), at1 = frag8(T2 + (32 + r) * 68 + ko);
        const bf16x8 bv = frag8(vT + (32 * hw + r) * 68 + ko);
        ua0 = MFMA32(at0, bv, ua0);
        ua1 = MFMA32(at1, bv, ua1);
      }
      if (valid) {
        uint4 u;
        bfu* up0 = segp + UF_OFF + ((hw * 2 + 0) * 64 + lane) * 16;
        bfu* up1 = segp + UF_OFF + ((hw * 2 + 1) * 64 + lane) * 16;
        u = {pack2(ua0[0], ua0[1]), pack2(ua0[2], ua0[3]), pack2(ua0[4], ua0[5]), pack2(ua0[6], ua0[7])}; *(uint4*)up0 = u;
        u = {pack2(ua0[8], ua0[9]), pack2(ua0[10], ua0[11]), pack2(ua0[12], ua0[13]), pack2(ua0[14], ua0[15])}; *(uint4*)(up0 + 8) = u;
        u = {pack2(ua1[0], ua1[1]), pack2(ua1[2], ua1[3]), pack2(ua1[4], ua1[5]), pack2(ua1[6], ua1[7])}; *(uint4*)up1 = u;
        u = {pack2(ua1[8], ua1[9]), pack2(ua1[10], ua1[11]), pack2(ua1[12], ua1[13]), pack2(ua1[14], ua1[15])}; *(uint4*)(up1 + 8) = u;
      }
    }
    __syncthreads();
  }
}

struct ScanOps { bf16x8 af[8]; bf16x8 b4[4]; uint4 u0, u1; float gl; float egv; };
DI void scan_load(ScanOps& q, const bfu* __restrict__ sp, const float* __restrict__ glbuf, const bfu* __restrict__ proj, int w, int lane, int sl,
                  int chain, int step) {
  if (w < 4) {
    const int mb = w & 1;
    if (w < 2) {
      const bfu* ap = sp + WF_OFF + (mb * 8 * 64 + lane) * 8;
#pragma unroll
      for (int k8 = 0; k8 < 8; ++k8) q.af[k8] = *(const bf16x8*)(ap + k8 * 512);
      const bfu* up = sp + UF_OFF + ((sl * 2 + mb) * 64 + lane) * 16;
      q.u0 = *(const uint4*)up; q.u1 = *(const uint4*)(up + 8);
    } else {
      const int b = chain >> 5, dir = (chain >> 4) & 1, qh = (chain & 15) >> 1;
      const int m = chain_row(b, dir, step * 64 + 32 * mb + (lane & 31));
      const bfu* ap = proj + (size_t)m * 4096 + qh * 128 + 8 * (lane >> 5);
#pragma unroll
      for (int k8 = 0; k8 < 8; ++k8) q.af[k8] = *(const bf16x8*)(ap + 16 * k8);
      q.egv = ((const float*)(sp + EG_OFF))[lane];
      const bfu* qp = sp + QKF_OFF + (mb * 4 * 64 + lane) * 8;
#pragma unroll
      for (int k4 = 0; k4 < 4; ++k4) q.b4[k4] = *(const bf16x8*)(qp + k4 * 512);
    }
  } else {
    const bfu* kp = sp + KDF_OFF + ((w - 4) * 4 * 64 + lane) * 8;
#pragma unroll
    for (int k4 = 0; k4 < 4; ++k4) q.b4[k4] = *(const bf16x8*)(kp + k4 * 512);
    q.gl = glbuf[chain * NCH + step];
  }
}

DI bfu* o_piece_ptr(bfu* o, bfu* octx2, int b, int dir, int hh, int sl, int step, int c, int piece) {
  const int m = chain_row(b, dir, step * 64 + c);
  const int col = hh * 128 + 32 * sl + piece * 8;
  if (step < 4 && dir == 1) return octx2 + (size_t)(b * CTX + (m - b * TPB)) * 2048 + col;
  return o + (size_t)m * 2048 + col;
}

DI void gdn_scan_seg(const bfu* __restrict__ seg, const float* __restrict__ glbuf, const bfu* __restrict__ proj, int s0, int s1, float* sstate,
                     bfu* o, bfu* octx2, char* smem) {
  bfu* Sb = (bfu*)smem;
  bfu* Vn = Sb + 32 * 136;
  bfu* Ot = Vn + 32 * 68;
  float* Eg = (float*)(Ot + 2 * 32 * 40);
  const int tid = opaque_tid(), w = tid >> 6, lane = tid & 63, r = lane & 31, h = lane >> 5;
  const int bid = opaque_bid();
  const int chain = (bid & 7) * 8 + (bid >> 5), sl = (bid >> 3) & 3;
  const int b = chain >> 5, dir = (chain >> 4) & 1, hh = chain & 15;
  f32x16 Sacc;
  float* sst = sstate + ((size_t)bid * 256 + (tid & 255)) * 16;
  if (s0 == 0) {
#pragma unroll
    for (int i = 0; i < 16; ++i) Sacc[i] = 0.f;
  } else if (w >= 4) {
#pragma unroll
    for (int i = 0; i < 4; ++i) { const float4 v = *(const float4*)(sst + 4 * i); Sacc[4 * i] = v.x; Sacc[4 * i + 1] = v.y; Sacc[4 * i + 2] = v.z; Sacc[4 * i + 3] = v.w; }
  }
  ScanOps cur;
  scan_load(cur, seg + (size_t)chain * SEG_STRIDE, glbuf, proj, w, lane, sl, chain, s0);
  for (int step = s0; step < s1; ++step) {
    ScanOps nxt;
    if (step + 1 < s1) scan_load(nxt, seg + ((size_t)(step + 1 - s0) * 64 + chain) * SEG_STRIDE, glbuf, proj, w, lane, sl, chain, step + 1);
    uint4 oldo0 = {0, 0, 0, 0}, oldo1 = {0, 0, 0, 0};
    if (step >= 68 && (w == 2 || w == 3)) {
      oldo0 = *(const uint4*)o_piece_ptr(o, octx2, b, dir, hh, sl, step, 32 * (w - 2) + (lane >> 2), lane & 3);
      oldo1 = *(const uint4*)o_piece_ptr(o, octx2, b, dir, hh, sl, step, 32 * (w - 2) + (lane >> 2) + 16, lane & 3);
    }
    if (w == 2) Eg[lane] = cur.egv;
    if (w >= 4) {
#pragma unroll
      for (int q = 0; q < 4; ++q) {
        uint2 ov = {pack2(Sacc[4 * q], Sacc[4 * q + 1]), pack2(Sacc[4 * q + 2], Sacc[4 * q + 3])};
        *(uint2*)(Sb + r * 136 + 32 * (w - 4) + 8 * q + 4 * h) = ov;
      }
    }
    __syncthreads();
    f32x16 acc;
    if (w < 4) {
      if (w < 2) {
        const uint32_t uw[8] = {cur.u0.x, cur.u0.y, cur.u0.z, cur.u0.w, cur.u1.x, cur.u1.y, cur.u1.z, cur.u1.w};
#pragma unroll
        for (int i = 0; i < 8; ++i) { acc[2 * i] = __uint_as_float(uw[i] << 16); acc[2 * i + 1] = __uint_as_float(uw[i] & 0xffff0000u); }
      } else {
#pragma unroll
        for (int i = 0; i < 16; ++i) acc[i] = 0.f;
      }
#pragma unroll
      for (int k8 = 0; k8 < 8; ++k8) {
        const bf16x8 bs = *(const bf16x8*)(Sb + r * 136 + 16 * k8 + 8 * h);
        acc = MFMA32(cur.af[k8], bs, acc);
      }
      if (w < 2) {
#pragma unroll
        for (int q = 0; q < 4; ++q) {
          uint2 ov = {pack2(acc[4 * q], acc[4 * q + 1]), pack2(acc[4 * q + 2], acc[4 * q + 3])};
          *(uint2*)(Vn + r * 68 + 32 * w + 8 * q + 4 * h) = ov;
        }
      } else {
#pragma unroll
        for (int q = 0; q < 4; ++q) {
          const float4 e4 = *(const float4*)(Eg + 32 * (w & 1) + 8 * q + 4 * h);
          acc[4 * q] *= e4.x; acc[4 * q + 1] *= e4.y; acc[4 * q + 2] *= e4.z; acc[4 * q + 3] *= e4.w;
        }
      }
    }
    __syncthreads();
    if (w >= 2) {
      bf16x8 bv[4];
#pragma unroll
      for (int k4 = 0; k4 < 4; ++k4) bv[k4] = frag8(Vn + r * 68 + 16 * k4 + 8 * h);
      if (w < 4) {
#pragma unroll
        for (int k4 = 0; k4 < 4; ++k4) acc = MFMA32(cur.b4[k4], bv[k4], acc);
        bfu* ot = Ot + (w - 2) * 32 * 40;
#pragma unroll
        for (int i = 0; i < 16; ++i) ot[crow(i, h) * 40 + r] = f2bf(acc[i]);
        __builtin_amdgcn_s_waitcnt(0xc07f);
        __builtin_amdgcn_wave_barrier();
#pragma unroll
        for (int u = 0; u < 2; ++u) {
          const int cl = (lane >> 2) + 16 * u, piece = lane & 3;
          const uint4 nv = *(const uint4*)(ot + cl * 40 + piece * 8);
          bfu* gp = o_piece_ptr(o, octx2, b, dir, hh, sl, step, 32 * (w - 2) + cl, piece);
          if (step < 68) *(uint4*)gp = nv;
          else {
            const uint4 ov = u == 0 ? oldo0 : oldo1;
            uint4 rv;
            rv.x = pack2(__uint_as_float(ov.x << 16) + __uint_as_float(nv.x << 16), __uint_as_float(ov.x & 0xffff0000u) + __uint_as_float(nv.x & 0xffff0000u));
            rv.y = pack2(__uint_as_float(ov.y << 16) + __uint_as_float(nv.y << 16), __uint_as_float(ov.y & 0xffff0000u) + __uint_as_float(nv.y & 0xffff0000u));
            rv.z = pack2(__uint_as_float(ov.z << 16) + __uint_as_float(nv.z << 16), __uint_as_float(ov.z & 0xffff0000u) + __uint_as_float(nv.z & 0xffff0000u));
            rv.w = pack2(__uint_as_float(ov.w << 16) + __uint_as_float(nv.w << 16), __uint_as_float(ov.w & 0xffff0000u) + __uint_as_float(nv.w & 0xffff0000u));
            *(uint4*)gp = rv;
          }
        }
      } else {
#pragma unroll
        for (int i = 0; i < 16; ++i) Sacc[i] *= cur.gl;
#pragma unroll
        for (int k4 = 0; k4 < 4; ++k4) Sacc = MFMA32(cur.b4[k4], bv[k4], Sacc);
      }
    }
    cur = nxt;
  }
  if (w >= 4) {
#pragma unroll
    for (int i = 0; i < 4; ++i) { float4 v = {Sacc[4 * i], Sacc[4 * i + 1], Sacc[4 * i + 2], Sacc[4 * i + 3]}; *(float4*)(sst + 4 * i) = v; }
  }
}

DI void gdn_chunked(const bfu* proj, const float* gab, const float* a_log, const float* dt_bias, bfu* seg, float* glbuf, bfu* o,
                    bfu* octx2, char* smem, const XcdBarrier& gbar, unsigned& lb_count) {
  float* sstate = glbuf + 16384;
  unsigned* prog = gbar.bar + 3520;
  const int bid = opaque_bid();
  const int my_chain = (bid & 7) * 8 + (bid >> 5);
  for (int s0 = 0; s0 < NCH;) {
    const int lim = s0 < 68 ? 68 : NCH;
    const int s1 = s0 + SEG_STEPS < lim ? s0 + SEG_STEPS : lim;
    gdn_prep(proj, gab, a_log, dt_bias, seg, glbuf, s0, s1, smem, prog, 4u * lb_count);
    xcd_barrier(gbar);
    gdn_scan_seg(seg, glbuf, proj, s0, s1, sstate, o, octx2, smem);
    asm volatile("s_waitcnt vmcnt(0)" ::: "memory");
    __syncthreads();
    if (opaque_tid() == 0) xb_add(prog + 8 * my_chain, 1u);
    lb_count += 1u;
    if (s1 >= NCH) xcd_barrier(gbar);
    s0 = s1;
  }
}

DI void gdn_post_phase(bfu* o, const bfu* octx2, const float* ng) {
  const int tid = opaque_tid(), lane = tid & 63, wid = tid >> 6;
  const int hl = lane >> 5, l32 = lane & 31;
  const float4 g = *(const float4*)(ng + l32 * 4);
  for (int m = opaque_bid() * 8 + wid; m < M; m += gridDim.x * 8) {
    const int b = m / TPB, p = m - b * TPB;
    bfu* orow = o + (size_t)m * 2048 + hl * 128 + l32 * 4;
    uint2 v[8], v2[8];
#pragma unroll
    for (int it = 0; it < 8; ++it) v[it] = *(const uint2*)(orow + it * 256);
    if (p < CTX) {
      const bfu* crow_ = octx2 + (size_t)(b * CTX + p) * 2048 + hl * 128 + l32 * 4;
#pragma unroll
      for (int it = 0; it < 8; ++it) v2[it] = *(const uint2*)(crow_ + it * 256);
    }
#pragma unroll
    for (int it = 0; it < 8; ++it) {
      float f0 = __uint_as_float(v[it].x << 16), f1 = __uint_as_float(v[it].x & 0xffff0000u);
      float f2 = __uint_as_float(v[it].y << 16), f3 = __uint_as_float(v[it].y & 0xffff0000u);
      if (p < CTX) {
        f0 += __uint_as_float(v2[it].x << 16); f1 += __uint_as_float(v2[it].x & 0xffff0000u);
        f2 += __uint_as_float(v2[it].y << 16); f3 += __uint_as_float(v2[it].y & 0xffff0000u);
      }
      float ss = f0 * f0 + f1 * f1 + f2 * f2 + f3 * f3;
#pragma unroll
      for (int off = 16; off >= 1; off >>= 1) ss += __shfl_xor(ss, off);
      const float rstd = rsqrtf(ss * (1.0f / 128.0f) + 1e-6f);
      uint2 ov = {pack2(f0 * rstd * g.x, f1 * rstd * g.y), pack2(f2 * rstd * g.z, f3 * rstd * g.w)};
      *(uint2*)(orow + it * 256) = ov;
    }
  }
}

DI void lru_conv_phase(const bfu* xb, const float* cw, const float* cb, bfu* xc) {
  const int total = M * 128;
  for (int it = opaque_bid() * NTHR + opaque_tid(); it < total; it += gridDim.x * NTHR) {
    const int m = it >> 7, c8 = (it & 127) * 8;
    const int b = m / TPB, p = m - b * TPB;
    const int lo = p < CTX ? 0 : CTX, hi = p < CTX ? CTX : TPB;
    const float4 cb0 = *(const float4*)(cb + c8), cb1 = *(const float4*)(cb + c8 + 4);
    float a0 = cb0.x, a1 = cb0.y, a2 = cb0.z, a3 = cb0.w, a4 = cb1.x, a5 = cb1.y, a6 = cb1.z, a7 = cb1.w;
#pragma unroll
    for (int j = 0; j < 4; ++j) {
      const int pp = p - 2 + j;
      if (pp >= lo && pp < hi) {
        const uint4 v = *(const uint4*)(xb + (size_t)(m - 2 + j) * 1024 + c8);
        const float4 w0 = *(const float4*)(cw + j * 1024 + c8), w1 = *(const float4*)(cw + j * 1024 + c8 + 4);
        a0 += w0.x * __uint_as_float(v.x << 16); a1 += w0.y * __uint_as_float(v.x & 0xffff0000u);
        a2 += w0.z * __uint_as_float(v.y << 16); a3 += w0.w * __uint_as_float(v.y & 0xffff0000u);
        a4 += w1.x * __uint_as_float(v.z << 16); a5 += w1.y * __uint_as_float(v.z & 0xffff0000u);
        a6 += w1.z * __uint_as_float(v.w << 16); a7 += w1.w * __uint_as_float(v.w & 0xffff0000u);
      }
    }
    uint4 o;
    o.x = (uint32_t)f2bf(a0) | ((uint32_t)f2bf(a1) << 16);
    o.y = (uint32_t)f2bf(a2) | ((uint32_t)f2bf(a3) << 16);
    o.z = (uint32_t)f2bf(a4) | ((uint32_t)f2bf(a5) << 16);
    o.w = (uint32_t)f2bf(a6) | ((uint32_t)f2bf(a7) << 16);
    *(uint4*)(xc + (size_t)m * 1024 + c8) = o;
  }
}

DI void lru_scan1(const bfu* la, const bfu* bb, float* cp, float* chh) {
  const int total = 2 * 2 * NCH * 512;
  for (int e = opaque_bid() * NTHR + opaque_tid(); e < total; e += gridDim.x * NTHR) {
    const int ch = (e & 511) * 2, r = e >> 9;
    const int j = r % NCH, bd = r / NCH, d = bd & 1, b = bd >> 1;
    float P0 = 1.f, P1 = 1.f, H0 = 0.f, H1 = 0.f;
    const int m0 = chain_row(b, d, j * 64);
    const long stride = d == 0 ? 2048 : -2048;
    const bfu* lp = la + ((size_t)m0 * 2 + d) * 1024 + ch;
    const bfu* bp = bb + ((size_t)m0 * 2 + d) * 1024 + ch;
    for (int t8 = 0; t8 < 64; t8 += 16) {
      uint32_t lv[16], bv[16];
#pragma unroll
      for (int u = 0; u < 16; ++u) { lv[u] = *(const uint32_t*)(lp + (t8 + u) * stride); bv[u] = *(const uint32_t*)(bp + (t8 + u) * stride); }
#pragma unroll
      for (int u = 0; u < 16; ++u) {
        const float a0 = __expf(__uint_as_float(lv[u] << 16)), a1 = __expf(__uint_as_float(lv[u] & 0xffff0000u));
        P0 *= a0; P1 *= a1;
        H0 = a0 * H0 + __uint_as_float(bv[u] << 16); H1 = a1 * H1 + __uint_as_float(bv[u] & 0xffff0000u);
      }
    }
    const size_t oi = (size_t)r * 1024 + ch;
    *(float2*)(cp + oi) = float2{P0, P1};
    *(float2*)(chh + oi) = float2{H0, H1};
  }
}
DI void lru_scan2(const float* cp, const float* chh, float* ci, char* smem) {
  float* gp = (float*)smem;
  float* gh = gp + 12 * 32;
  const int tid = opaque_tid();
  const int g = tid >> 5, cl = tid & 31;
  for (int task = opaque_bid(); task < 4 * 32; task += gridDim.x) {
    const int bd = task >> 5, ch = (task & 31) * 32 + cl;
    float pv[11], hv[11];
    if (g < 12) {
#pragma unroll
      for (int u = 0; u < 11; ++u) { const size_t idx = ((size_t)bd * NCH + g * 11 + u) * 1024 + ch; pv[u] = cp[idx]; hv[u] = chh[idx]; }
      float P = 1.f, H = 0.f;
#pragma unroll
      for (int u = 0; u < 11; ++u) { H = pv[u] * H + hv[u]; P *= pv[u]; }
      gp[g * 32 + cl] = P; gh[g * 32 + cl] = H;
    }
    __syncthreads();
    if (g < 12) {
      float carry = 0.f;
      for (int q = 0; q < g; ++q) carry = gp[q * 32 + cl] * carry + gh[q * 32 + cl];
#pragma unroll
      for (int u = 0; u < 11; ++u) {
        ci[((size_t)bd * NCH + g * 11 + u) * 1024 + ch] = carry;
        carry = pv[u] * carry + hv[u];
      }
    }
    __syncthreads();
  }
}
DI void lru_scan3(const bfu* la, const bfu* bb, const float* ci, const bfu* sg, bfu* y) {
  const int total = 2 * NCH * 512;
  for (int e = opaque_bid() * NTHR + opaque_tid(); e < total; e += gridDim.x * NTHR) {
    const int ch = (e & 511) * 2, r = e >> 9;
    const int tc = r % NCH, b = r / NCH;
    const int jb = tc < 4 ? 3 - tc : 135 - tc;
    const int mbase = b * TPB + tc * 64;
    float2 cv = *(const float2*)(ci + ((size_t)(b * 2 + 1) * NCH + jb) * 1024 + ch);
    float c0 = cv.x, c1 = cv.y;
    {
      const bfu* lp = la + ((size_t)(mbase + 63) * 2 + 1) * 1024 + ch;
      const bfu* bp = bb + ((size_t)(mbase + 63) * 2 + 1) * 1024 + ch;
      bfu* yp = y + (size_t)(mbase + 63) * 1024 + ch;
      for (int t8 = 0; t8 < 64; t8 += 16) {
        uint32_t lv[16], bv[16];
#pragma unroll
        for (int u = 0; u < 16; ++u) { lv[u] = *(const uint32_t*)(lp - (t8 + u) * 2048); bv[u] = *(const uint32_t*)(bp - (t8 + u) * 2048); }
#pragma unroll
        for (int u = 0; u < 16; ++u) {
          c0 = __expf(__uint_as_float(lv[u] << 16)) * c0 + __uint_as_float(bv[u] << 16);
          c1 = __expf(__uint_as_float(lv[u] & 0xffff0000u)) * c1 + __uint_as_float(bv[u] & 0xffff0000u);
          *(uint32_t*)(yp - (t8 + u) * 1024) = pack2(c0, c1);
        }
      }
    }
    cv = *(const float2*)(ci + ((size_t)(b * 2 + 0) * NCH + tc) * 1024 + ch);
    c0 = cv.x; c1 = cv.y;
    {
      const bfu* lp = la + ((size_t)mbase * 2 + 0) * 1024 + ch;
      const bfu* bp = bb + ((size_t)mbase * 2 + 0) * 1024 + ch;
      bfu* yp = y + (size_t)mbase * 1024 + ch;
      const bfu* sp = sg + (size_t)mbase * 1024 + ch;
      for (int t8 = 0; t8 < 64; t8 += 16) {
        uint32_t lv[16], bv[16], yv[16], sv[16];
#pragma unroll
        for (int u = 0; u < 16; ++u) {
          lv[u] = *(const uint32_t*)(lp + (t8 + u) * 2048); bv[u] = *(const uint32_t*)(bp + (t8 + u) * 2048);
          yv[u] = *(const uint32_t*)(yp + (t8 + u) * 1024); sv[u] = *(const uint32_t*)(sp + (t8 + u) * 1024);
        }
#pragma unroll
        for (int u = 0; u < 16; ++u) {
          c0 = __expf(__uint_as_float(lv[u] << 16)) * c0 + __uint_as_float(bv[u] << 16);
          c1 = __expf(__uint_as_float(lv[u] & 0xffff0000u)) * c1 + __uint_as_float(bv[u] & 0xffff0000u);
          const float o0 = (c0 + __uint_as_float(yv[u] << 16)) * __uint_as_float(sv[u] << 16);
          const float o1 = (c1 + __uint_as_float(yv[u] & 0xffff0000u)) * __uint_as_float(sv[u] & 0xffff0000u);
          *(uint32_t*)(yp + (t8 + u) * 1024) = pack2(o0, o1);
        }
      }
    }
  }
}

struct BaseIdent { DI long operator()(int r) const { return r; } };
struct BaseGdnIn { DI long operator()(int r) const { return r < 4096 ? (long)r : (r < 4160 ? (long)(6144 + r - 4096) : -1L); } };
struct BaseGdnZ { DI long operator()(int r) const { return 4096 + r; } };
struct BaseLruGate {
  int kind;
  DI long operator()(int r) const {
    const int k = (r >> 5) & 1;
    if (k != kind) return -1L;
    const int cc = r & 31, grp = r >> 6;
    const int cg8 = grp & 7, d = (grp >> 3) & 1, nb = grp >> 4;
    return (long)(d * 4 + nb) * 65536 + cg8 * 32 + cc;
  }
};

DI void lru_gate_transpose(const float* wr, const float* wi, bfu* dst, char* smem) {
  float* tile = (float*)smem;
  const int tid = opaque_tid();
  for (int t = opaque_bid(); t < 64 * 4; t += gridDim.x) {
    const int r0 = (t >> 2) * 64, k0 = (t & 3) * 64;
    {
      const int rr = tid & 63;
      const long b_r = BaseLruGate{0}(r0 + rr), b_i = BaseLruGate{1}(r0 + rr);
      const float* src = b_r >= 0 ? wr + b_r : wi + b_i;
#pragma unroll
      for (int i = 0; i < 8; ++i) {
        const int kk = i * 8 + (tid >> 6);
        tile[kk * 65 + rr] = src[(long)(k0 + kk) * 256];
      }
    }
    __syncthreads();
#pragma unroll
    for (int i = 0; i < 8; ++i) {
      const int e = i * 512 + tid;
      const int rr = e >> 6, kk = e & 63;
      dst[(size_t)(r0 + rr) * 256 + k0 + kk] = f2bf(tile[kk * 65 + rr]);
    }
    __syncthreads();
  }
}

__global__ void __launch_bounds__(NTHR) fwd_megakernel(Params p) {
  cg::grid_group grid = cg::this_grid();
  __shared__ __attribute__((aligned(16))) char smem[151552];
  __shared__ uint4 xb_words;
  if (threadIdx.x == 0) xb_words = make_uint4(0u, 0u, 0u, 0u);
  __syncthreads();
  const XcdBarrier gbar = xcd_barrier_post((unsigned*)(p.ws + OFF_BAR), (volatile LAS unsigned*)&xb_words);
  char* ws = p.ws;
  float* mod = (float*)(ws + OFF_MOD);
  float* ctxres = (float*)(ws + OFF_CTXRES);
  bfu* wt = (bfu*)(ws + OFF_WT);
  bfu* h = (bfu*)(ws + OFF_H);

  mod_phase(p, mod, smem);
  transpose_phase(p.gdn_w_in, 6208, 1024, 4224, wt, BaseGdnIn(), smem);
  for (int i = opaque_bid() * NTHR + opaque_tid(); i < 512 * 1024 / 4; i += gridDim.x * NTHR)
    ((float4*)ctxres)[i] = ((const float4*)p.ctx)[i];
  grid.sync();

  unsigned lb_count = 0;
  for (int layer = 0; layer < 4; ++layer) {
    const int j = layer >> 1;
    const bool colmajor = ((layer + layer / 2) & 1) == 1;
    const float* xsrc = layer == 0 ? p.x : p.out;
    const float* modl = mod + (size_t)layer * 3 * 3072;
    if ((layer & 1) == 0) {
      bfu* proj = (bfu*)(ws + OFF_PROJ);
      bfu* halo = (bfu*)(ws + OFF_HALO);
      bfu* o = (bfu*)(ws + OFF_O);
      bfu* octx2 = (bfu*)(ws + OFF_OCTX2);
      float* gab = (float*)(ws + OFF_GG);
      const float* w_in = p.gdn_w_in + (size_t)j * 1024 * 6208;
      if (layer != 0) transpose_phase(w_in, 6208, 1024, 4224, wt, BaseGdnIn(), smem);
      norm_phase(xsrc, ctxres, p.norm_g + layer * 1024, modl, colmajor, h);
      xcd_barrier(gbar);
      gemm_phase(h, 1024, wt, 1024, 1024, 68, 33, KOffZero(),
                 EpiGdn1Conv{proj, gab, p.gdn_conv + (size_t)j * 4 * 4096}, smem, true);
      xcd_barrier(gbar);
      gdn_chunked(proj, gab, p.gdn_a_log + j * 32, p.gdn_dt_bias + j * 32, h, (float*)halo, o, octx2, smem, gbar, lb_count);
      norm_phase(xsrc, ctxres, p.norm_g + layer * 1024, modl, colmajor, h);
      transpose_phase(w_in, 6208, 1024, 2048, wt, BaseGdnZ(), smem);
      transpose_phase(p.gdn_w_out + (size_t)j * 2048 * 1024, 1024, 2048, 1024, wt + 2048 * 1024, BaseIdent(), smem);
      xcd_barrier(gbar);
      gemm_phase(h, 1024, wt, 1024, 1024, 66, 16, KOffZero(), EpiZGate{o, octx2, p.gdn_norm_g + j * 128}, smem);
      xcd_barrier(gbar);
      gemm_phase(o, 2048, wt + 2048 * 1024, 2048, 2048, 66, 8, KOffZero(),
                 EpiResid{xsrc, p.out, ctxres, modl, colmajor, layer < 3}, smem);
      xcd_barrier(gbar);
    } else {
      bfu* xb = (bfu*)(ws + OFF_XB);
      bfu* sg = (bfu*)(ws + OFF_SG);
      bfu* la = (bfu*)(ws + OFF_LA);
      bfu* bb = (bfu*)(ws + OFF_BB);
      float* cp = (float*)(ws + OFF_CP);
      float* chh = (float*)(ws + OFF_CH);
      float* ci = (float*)(ws + OFF_CI);
      bfu* xc = xb;
      bfu* yin = h;
      bfu* wt_in = wt;
      bfu* wt_gate = wt + 2048 * 1024;
      bfu* wt_out = wt_gate + 4096 * 256;
      transpose_phase(p.lru_w_in + (size_t)j * 1024 * 2048, 2048, 1024, 2048, wt_in, BaseIdent(), smem);
      lru_gate_transpose(p.lru_w_r + (size_t)j * 2 * 4 * 65536, p.lru_w_i + (size_t)j * 2 * 4 * 65536, wt_gate, smem);
      transpose_phase(p.lru_w_out + (size_t)j * 1024 * 1024, 1024, 1024, 1024, wt_out, BaseIdent(), smem);
      norm_phase(xsrc, ctxres, p.norm_g + layer * 1024, modl, colmajor, h);
      float* spl = (float*)(ws + OFF_SPL);
      for (int i = opaque_bid() * NTHR + opaque_tid(); i < 2048; i += gridDim.x * NTHR) spl[i] = softplus_f(-p.lru_lambda[j * 2048 + i]);
      xcd_barrier(gbar);
      gemm_phase(h, 1024, wt_in, 1024, 1024, 68, 16, KOffZero(),
                 EpiLruInConv{xc, sg, p.lru_conv_w + (size_t)j * 4 * 1024, p.lru_conv_b + j * 1024}, smem, true);
      xcd_barrier(gbar);
      gemm_phase(xc, 1024, wt_gate, 256, 256, 66, 32, KOffLruGate(),
                 EpiLruGate{xc, la, bb, p.lru_b_r + j * 2048, p.lru_b_i + j * 2048, spl}, smem);
      xcd_barrier(gbar);
      lru_scan1(la, bb, cp, chh);
      xcd_barrier(gbar);
      lru_scan2(cp, chh, ci, smem);
      xcd_barrier(gbar);
      lru_scan3(la, bb, ci, sg, yin);
      xcd_barrier(gbar);
      gemm_phase(yin, 1024, wt_out, 1024, 1024, 66, 8, KOffZero(),
                 EpiResid{xsrc, p.out, ctxres, modl, colmajor, layer < 3}, smem);
      xcd_barrier(gbar);
    }
  }
  final_norm_phase(p.out, p.final_g);
}

extern "C" void kernel_launch(void* const* d_in, const int* in_sizes, int n_in, void* d_out, int out_size, void* d_ws,
                              size_t ws_size, hipStream_t stream) {
  static int grid_blocks = 0;
  if (!grid_blocks) {
    int dev = 0, cus = 0, per_cu = 0;
    (void)hipGetDevice(&dev);
    (void)hipDeviceGetAttribute(&cus, hipDeviceAttributeMultiprocessorCount, dev);
    (void)hipOccupancyMaxActiveBlocksPerMultiprocessor(&per_cu, fwd_megakernel, NTHR, 0);
    if (per_cu > 1) per_cu = 1;
    grid_blocks = cus * per_cu;
  }
  Params p{};
  p.x = (const float*)d_in[0]; p.c = (const float*)d_in[1]; p.ctx = (const float*)d_in[2]; p.c_ctx = (const float*)d_in[3];
  p.mod_w = (const float*)d_in[4]; p.mod_b = (const float*)d_in[5]; p.norm_g = (const float*)d_in[6];
  p.gdn_w_in = (const float*)d_in[7]; p.gdn_conv = (const float*)d_in[8]; p.gdn_a_log = (const float*)d_in[9];
  p.gdn_dt_bias = (const float*)d_in[10]; p.gdn_norm_g = (const float*)d_in[11]; p.gdn_w_out = (const float*)d_in[12];
  p.lru_w_in = (const float*)d_in[13]; p.lru_conv_w = (const float*)d_in[14]; p.lru_conv_b = (const float*)d_in[15];
  p.lru_w_r = (const float*)d_in[16]; p.lru_b_r = (const float*)d_in[17]; p.lru_w_i = (const float*)d_in[18];
  p.lru_b_i = (const float*)d_in[19]; p.lru_lambda = (const float*)d_in[20]; p.lru_w_out = (const float*)d_in[21];
  p.final_g = (const float*)d_in[22];
  p.out = (float*)d_out;
  p.ws = (char*)d_ws;
  (void)hipMemsetAsync((char*)d_ws + OFF_BAR, 0, 16384, stream);
  void* args[] = {&p};
  hipError_t e = hipLaunchCooperativeKernel((void*)fwd_megakernel, dim3(grid_blocks), dim3(NTHR), args, 0, stream);
  if (e != hipSuccess) fprintf(stderr, "cooperative launch failed: %s (grid %d)\n", hipGetErrorString(e), grid_blocks);
}
```

```cpp
#include <hip/hip_runtime.h>
#include <hip/hip_cooperative_groups.h>
#include <stdint.h>
#include <cstdio>
namespace cg = cooperative_groups;

typedef unsigned short bfu;
using bf16x8 = __attribute__((ext_vector_type(8))) short;
using f32x4 = __attribute__((ext_vector_type(4))) float;

#define DI __device__ __forceinline__
constexpr int NTHR = 512;
constexpr int D = 1024, SEQ = 8192, CTX = 256, TPB = 8448, M = 16896;
constexpr int NCH = 132;

DI int opaque_tid() { int t = threadIdx.x; asm volatile("" : "+v"(t)); return t; }
DI int opaque_bid() { int b = blockIdx.x; asm volatile("" : "+s"(b)); return b; }

#define XB_TMO      128
#define XB_XCNT(j)  (256  + 64 * (j))
#define XB_XSUB(j)  (1280 + 64 * (j))
#define XB_XGEN(j)  (2304 + 64 * (j))
#define XB_TOP      3328
#define XB_TOPGEN   3392
#define XCD_BAR_WORDS 3456
#define XB_SPIN_CAP (1u << 18)
#define LAS __attribute__((address_space(3)))

__device__ __forceinline__ unsigned xb_ld(unsigned* p)              { return __hip_atomic_load(p, __ATOMIC_RELAXED, __HIP_MEMORY_SCOPE_AGENT); }
__device__ __forceinline__ unsigned xb_add(unsigned* p, unsigned v) { return __hip_atomic_fetch_add(p, v, __ATOMIC_RELAXED, __HIP_MEMORY_SCOPE_AGENT); }
__device__ __forceinline__ unsigned xb_xcc_id() { return (unsigned)__builtin_amdgcn_s_getreg((3 << 11) | 20) & 0xFu; }
#define XB_SPIN(cond, bar) do { unsigned _sp = 0; while (cond) { __builtin_amdgcn_s_sleep(1); \
    if ((++_sp & 255u) == 0u) { if (xb_ld(&(bar)[XB_TMO])) break; if (_sp > XB_SPIN_CAP) { atomicAdd(&(bar)[XB_TMO], 1u); break; } } } } while (0)

struct XcdBarrier {
    unsigned* bar; unsigned x;
    volatile LAS unsigned* st;
};

__device__ __forceinline__ XcdBarrier xcd_barrier_post(unsigned* bar, volatile LAS unsigned* st) {
    XcdBarrier b; b.bar = bar; b.x = xb_xcc_id(); b.st = st;
    if (threadIdx.x == 0) (void)xb_add(&bar[XB_XCNT(b.x)], 1u);
    return b;
}
__device__ __forceinline__ void xcd_barrier_complete(unsigned* bar, unsigned x, unsigned& nloc, unsigned& nx) {
    const unsigned G = gridDim.x * gridDim.y * gridDim.z;
    unsigned sum, cnt, mine, sp = 0u;
    for (;;) {
        sum = 0u; cnt = 0u; mine = 0u;
#pragma unroll
        for (unsigned j = 0; j < 16; ++j) { const unsigned c = xb_ld(&bar[XB_XCNT(j)]); sum += c; cnt += (c > 0u) ? 1u : 0u; mine = (j == x) ? c : mine; }
        if (sum == G) break;
        __builtin_amdgcn_s_sleep(1);
        if ((++sp & 255u) == 0u) { if (xb_ld(&bar[XB_TMO])) break; if (sp > XB_SPIN_CAP) { atomicAdd(&bar[XB_TMO], 1u); break; } }
    }
    nloc = mine > 0u ? mine : 1u; nx = cnt > 0u ? cnt : 1u;
}

__device__ __forceinline__ void xcd_barrier(const XcdBarrier& b) {
    asm volatile("s_waitcnt vmcnt(0)" ::: "memory");
    __syncthreads();
    if (threadIdx.x == 0) {
        unsigned* bar = b.bar;
        __builtin_amdgcn_s_waitcnt(0);
        unsigned nloc = b.st[0], nx = b.st[1];
        if (nloc == 0u) { xcd_barrier_complete(bar, b.x, nloc, nx); b.st[0] = nloc; b.st[1] = nx; }
        const unsigned old = xb_add(&bar[XB_XSUB(b.x)], 1u);
        const unsigned gen = old / nloc;
        if (old + 1u == (gen + 1u) * nloc) {
            __builtin_amdgcn_fence(__ATOMIC_RELEASE, "agent");
            asm volatile("s_waitcnt vmcnt(0)" ::: "memory");
            const unsigned og = xb_add(&bar[XB_TOP], 1u);
            const unsigned tg = og / nx;
            if (og + 1u == (tg + 1u) * nx) xb_add(&bar[XB_TOPGEN], 1u);
            else XB_SPIN(xb_ld(&bar[XB_TOPGEN]) == tg, bar);
            __builtin_amdgcn_fence(__ATOMIC_ACQUIRE, "agent");
            xb_add(&bar[XB_XGEN(b.x)], 1u);
            asm volatile("s_waitcnt vmcnt(0)" ::: "memory");
        } else {
            XB_SPIN(xb_ld(&bar[XB_XGEN(b.x)]) == gen, bar);
            __builtin_amdgcn_fence(__ATOMIC_ACQUIRE, "agent");
            asm volatile("s_waitcnt vmcnt(0)" ::: "memory");
        }
    }
    __syncthreads();
}


__device__ __forceinline__ void xcd_barrier_exec(const XcdBarrier& b) {
    asm volatile("s_waitcnt vmcnt(0)" ::: "memory");
    __syncthreads();
    if (threadIdx.x == 0) {
        unsigned* bar = b.bar;
        __builtin_amdgcn_s_waitcnt(0);
        unsigned nloc = b.st[0], nx = b.st[1];
        if (nloc == 0u) { xcd_barrier_complete(bar, b.x, nloc, nx); b.st[0] = nloc; b.st[1] = nx; }
        const unsigned old = xb_add(&bar[XB_XSUB(b.x)], 1u);
        const unsigned gen = old / nloc;
        if (old + 1u == (gen + 1u) * nloc) {
            asm volatile("s_waitcnt vmcnt(0)" ::: "memory");
            const unsigned og = xb_add(&bar[XB_TOP], 1u);
            const unsigned tg = og / nx;
            if (og + 1u == (tg + 1u) * nx) xb_add(&bar[XB_TOPGEN], 1u);
            else XB_SPIN(xb_ld(&bar[XB_TOPGEN]) == tg, bar);
            xb_add(&bar[XB_XGEN(b.x)], 1u);
            asm volatile("s_waitcnt vmcnt(0)" ::: "memory");
        } else {
            XB_SPIN(xb_ld(&bar[XB_XGEN(b.x)]) == gen, bar);
            asm volatile("s_waitcnt vmcnt(0)" ::: "memory");
        }
    }
    __syncthreads();
}


constexpr size_t OFF_BAR = 268435456 - 16384;
DI void light_barrier(unsigned* cnt, unsigned target) {
  asm volatile("s_waitcnt vmcnt(0)" ::: "memory");
  __syncthreads();
  if (threadIdx.x == 0) {
    xb_add(cnt, 1u);
    unsigned sp = 0;
    while (xb_ld(cnt) < target) { __builtin_amdgcn_s_sleep(1); if (++sp > (1u << 22)) break; }
  }
  __syncthreads();
}
typedef __attribute__((ext_vector_type(2))) float f32x2_t;
typedef __attribute__((ext_vector_type(2))) __bf16 bf16x2_t;
DI uint32_t pack2(float a, float b) { f32x2_t v = {a, b}; return __builtin_bit_cast(uint32_t, __builtin_convertvector(v, bf16x2_t)); }
DI bfu f2bf(float x) { return (bfu)(pack2(x, x) & 0xffffu); }
DI float bf2f(bfu x) { return __uint_as_float(((uint32_t)x) << 16); }
DI float sigmoid_f(float x) { return __builtin_amdgcn_rcpf(1.f + __expf(-x)); }
DI float silu_f(float x) { return x * sigmoid_f(x); }
DI float one_minus_exp(float y) { return y > -0.03f ? -y * (1.f + y * (0.5f + y * 0.16666667f)) : 1.f - __expf(y); }
DI float softplus_f(float x) { return x > 20.f ? x : log1pf(__expf(x)); }
DI float wave_sum(float v) {
#pragma unroll
  for (int o = 32; o >= 1; o >>= 1) v += __shfl_xor(v, o);
  return v;
}

struct Params {
  const float *x, *c, *ctx, *c_ctx, *mod_w, *mod_b, *norm_g, *gdn_w_in, *gdn_conv, *gdn_a_log, *gdn_dt_bias, *gdn_norm_g,
      *gdn_w_out, *lru_w_in, *lru_conv_w, *lru_conv_b, *lru_w_r, *lru_b_r, *lru_w_i, *lru_b_i, *lru_lambda, *lru_w_out, *final_g;
  float* out;
  char* ws;
};

constexpr size_t OFF_MOD = 0;
constexpr size_t OFF_CTXRES = OFF_MOD + 147456;
constexpr size_t OFF_WT = OFF_CTXRES + 2097152;
constexpr size_t OFF_H = OFF_WT + 8650752;
constexpr size_t OFF_L = OFF_H + 34603008;
constexpr size_t OFF_PROJ = OFF_L;
constexpr size_t OFF_HALO = OFF_PROJ + 138412032;
constexpr size_t OFF_O = OFF_HALO + 6488064;
constexpr size_t OFF_OCTX2 = OFF_O + 69206016;
constexpr size_t OFF_GG = OFF_OCTX2 + 2097152;
constexpr size_t OFF_GB = OFF_GG + 2162688;
constexpr size_t END_GDN = OFF_GB + 2162688;
constexpr size_t OFF_XB = OFF_L;
constexpr size_t OFF_SG = OFF_XB + 34603008;
constexpr size_t OFF_LA = OFF_SG + 34603008;
constexpr size_t OFF_BB = OFF_LA + 69206016;
constexpr size_t OFF_CP = OFF_BB + 69206016;
constexpr size_t OFF_CH = OFF_CP + 2162688;
constexpr size_t OFF_CI = OFF_CH + 2162688;
constexpr size_t OFF_SPL = OFF_CI + 2162688;
constexpr size_t END_LRU = OFF_SPL + 8192;
static_assert(END_GDN <= 268435456, "ws overflow gdn");
static_assert(END_LRU <= 268435456, "ws overflow lru");

DI int res_row(int m, bool colmajor) {
  int b = m / TPB, p = m - b * TPB;
  if (p < CTX) return -(b * CTX + p) - 1;
  int s = p - CTX;
  int t = colmajor ? ((s & 127) * 64 + (s >> 7)) : s;
  return b * SEQ + t;
}
DI int chain_row(int b, int dir, int pos) {
  int p = dir == 0 ? pos : (pos < CTX ? (CTX - 1 - pos) : (TPB + CTX - 1 - pos));
  return b * TPB + p;
}

template <class BaseF>
DI void transpose_phase(const float* __restrict__ src, int ld, int K, int nrows, bfu* __restrict__ dst, BaseF basef, char* smem,
                        int t_start = -1, int t_stride = 0) {
  float* tile = (float*)smem;
  const int tid = opaque_tid();
  const int rt = nrows / 64, kt = K / 64;
  if (t_start < 0) { t_start = opaque_bid(); t_stride = gridDim.x; }
  for (int t = t_start; t < rt * kt; t += t_stride) {
    const int r0 = (t / kt) * 64, k0 = (t % kt) * 64;
    {
      const int rr = tid & 63;
      const long base = basef(r0 + rr);
#pragma unroll
      for (int i = 0; i < 8; ++i) {
        const int kk = i * 8 + (tid >> 6);
        tile[kk * 65 + rr] = base < 0 ? 0.f : src[base + (long)(k0 + kk) * ld];
      }
    }
    __syncthreads();
#pragma unroll
    for (int i = 0; i < 8; ++i) {
      const int e = i * 512 + tid;
      const int rr = e >> 6, kk = e & 63;
      dst[(size_t)(r0 + rr) * K + k0 + kk] = f2bf(tile[kk * 65 + rr]);
    }
    __syncthreads();
  }
}

struct NoFill { DI void operator()(int, int) const {} };
template <class Epi, class KOff, class Fill = NoFill>
DI void gemm_phase(const bfu* __restrict__ A, int lda, const bfu* __restrict__ Bt, int ldb, int K, int Mt, int Nt, KOff koff,
                   Epi epi, char* smem, bool gdnmap = false, Fill fill = Fill()) {
  bfu* As = (bfu*)smem;
  bfu* Bs = As + 2 * 256 * 72;
  const int ntiles = Mt * Nt;
  const int nk = K / 64;
  int tile = opaque_bid();
  if (tile >= ntiles) return;
  const int tid = opaque_tid(), lane = tid & 63, wid = tid >> 6;
  const int wm = wid >> 1, wn = wid & 1;
  const int r16 = lane & 15, quad = lane >> 4;
  const int arow = tid >> 3, akq = tid & 7;
  uint4 p0, p1, p2, p3, p4, p5, q0, q1, q2, q3, q4, q5;
#define G_LOAD(x0, x1, x2, x3, x4, x5, kt_) do { const bfu* ap_ = ag + (kt_) * 64; const bfu* bp_ = bg + (kt_) * 64; \
      x0 = *(const uint4*)(ap_); x1 = *(const uint4*)(ap_ + (size_t)64 * lda); x2 = *(const uint4*)(ap_ + (size_t)128 * lda); x3 = *(const uint4*)(ap_ + (size_t)192 * lda); \
      x4 = *(const uint4*)(bp_); x5 = *(const uint4*)(bp_ + (size_t)64 * ldb); } while (0)
#define G_STORE(x0, x1, x2, x3, x4, x5, buf_) do { bfu* as_ = As + ((buf_) * 256 + arow) * 72 + akq * 8; bfu* bs_ = Bs + ((buf_) * 128 + arow) * 72 + akq * 8; \
      *(uint4*)(as_) = x0; *(uint4*)(as_ + 64 * 72) = x1; *(uint4*)(as_ + 128 * 72) = x2; *(uint4*)(as_ + 192 * 72) = x3; \
      *(uint4*)(bs_) = x4; *(uint4*)(bs_ + 64 * 72) = x5; } while (0)
#define R0 p0, p1, p2, p3, p4, p5
#define R1 q0, q1, q2, q3, q4, q5
#define G_LOADR(R, kt_) G_LOAD(R, kt_)
#define G_STORER(R, buf_) G_STORE(R, buf_)
#define G_COMPUTE(buf_) do { _Pragma("unroll") for (int ks_ = 0; ks_ < 2; ++ks_) { bf16x8 af[4], bfr[4]; \
      _Pragma("unroll") for (int i = 0; i < 4; ++i) af[i] = *(const bf16x8*)(As + ((buf_) * 256 + wm * 64 + i * 16 + r16) * 72 + ks_ * 32 + quad * 8); \
      _Pragma("unroll") for (int j = 0; j < 4; ++j) bfr[j] = *(const bf16x8*)(Bs + ((buf_) * 128 + wn * 64 + j * 16 + r16) * 72 + ks_ * 32 + quad * 8); \
      _Pragma("unroll") for (int i = 0; i < 4; ++i) _Pragma("unroll") for (int j = 0; j < 4; ++j) \
        acc[i][j] = __builtin_amdgcn_mfma_f32_16x16x32_bf16(af[i], bfr[j], acc[i][j], 0, 0, 0); } } while (0)
  int mt = tile / Nt, nt = tile - mt * Nt;
#define M_BASE(mt_) (gdnmap ? (((mt_) / 34) * TPB + (((mt_) % 34) == 0 ? 0 : 254 + 253 * (((mt_) % 34) - 1))) : (mt_) * 256)
  const bfu* ag = A + (size_t)(M_BASE(mt) + arow) * lda + koff(nt) + akq * 8;
  const bfu* bg = Bt + (size_t)(nt * 128 + arow) * ldb + akq * 8;
  G_LOADR(R0, 0);
  G_LOADR(R1, 1);
  if (__builtin_amdgcn_readfirstlane(tid) >= 256) __builtin_amdgcn_s_setprio(1);
  for (;;) {
    const int cm0 = M_BASE(mt), cn0 = nt * 128, cnt = nt;
    f32x4 acc[4][4];
#pragma unroll
    for (int i = 0; i < 4; ++i)
#pragma unroll
      for (int j = 0; j < 4; ++j) acc[i][j] = f32x4{0.f, 0.f, 0.f, 0.f};
    G_STORER(R0, 0);
    p0 = q0; p1 = q1; p2 = q2; p3 = q3; p4 = q4; p5 = q5;
    G_LOADR(R1, 2);
    __syncthreads();
    for (int kt = 0; kt < nk; kt += 2) {
      G_STORER(R0, 1);
      if (kt + 3 < nk) G_LOADR(R0, kt + 3);
      G_COMPUTE(0);
      __syncthreads();
      if (kt + 2 < nk) G_STORER(R1, 0);
      if (kt + 4 < nk) G_LOADR(R1, kt + 4);
      G_COMPUTE(1);
      __syncthreads();
    }
    tile += gridDim.x;
    const bool more = tile < ntiles;
    if (more) {
      mt = tile / Nt; nt = tile - mt * Nt;
      ag = A + (size_t)(M_BASE(mt) + arow) * lda + koff(nt) + akq * 8;
      bg = Bt + (size_t)(nt * 128 + arow) * ldb + akq * 8;
      G_LOADR(R0, 0);
      G_LOADR(R1, 1);
    }
    float* Cs = (float*)smem;
#pragma unroll
    for (int i = 0; i < 4; ++i)
#pragma unroll
      for (int j = 0; j < 4; ++j)
#pragma unroll
        for (int e = 0; e < 4; ++e) Cs[(wm * 64 + i * 16 + quad * 4 + e) * 132 + wn * 64 + j * 16 + r16] = acc[i][j][e];
    __syncthreads();
    epi(cm0, cn0, cnt, Cs, tid);
    __syncthreads();
    if (!more) break;
  }
  __builtin_amdgcn_s_setprio(0);
#undef G_LOAD
#undef G_STORE
#undef G_LOADR
#undef G_STORER
#undef R0
#undef R1
#undef G_COMPUTE
#undef M_BASE
  {
    const int rem = ntiles % (int)gridDim.x, bidf = opaque_bid();
    if (rem != 0 && bidf >= rem) fill(bidf - rem, (int)gridDim.x - rem);
  }
}

struct KOffZero { DI int operator()(int) const { return 0; } };
struct KOffLruGate { DI int operator()(int nt) const { return (nt >> 3) * 256; } };

DI void ld8(const float* Cs, int row, int col8, float (&v)[8]) {
  const float4 a = *(const float4*)(Cs + row * 132 + col8), b = *(const float4*)(Cs + row * 132 + col8 + 4);
  v[0] = a.x; v[1] = a.y; v[2] = a.z; v[3] = a.w; v[4] = b.x; v[5] = b.y; v[6] = b.z; v[7] = b.w;
}
DI uint4 pack8(const float (&v)[8]) { uint4 o = {pack2(v[0], v[1]), pack2(v[2], v[3]), pack2(v[4], v[5]), pack2(v[6], v[7])}; return o; }
DI void unpack8(const uint4 u, float (&v)[8]) {
  v[0] = __uint_as_float(u.x << 16); v[1] = __uint_as_float(u.x & 0xffff0000u); v[2] = __uint_as_float(u.y << 16); v[3] = __uint_as_float(u.y & 0xffff0000u);
  v[4] = __uint_as_float(u.z << 16); v[5] = __uint_as_float(u.z & 0xffff0000u); v[6] = __uint_as_float(u.w << 16); v[7] = __uint_as_float(u.w & 0xffff0000u);
}

struct EpiGdn1 {
  bfu* proj; bfu* halo; float* ab;
  DI void operator()(int m0, int n0, int nt, const float* Cs, int tid) const {
    if (nt < 32) {
#pragma unroll
      for (int k = 0; k < 8; ++k) {
        const int c = tid + 512 * k, row = c >> 4, col8 = (c & 15) * 8;
        float v[8]; ld8(Cs, row, col8, v);
        const uint4 pv = pack8(v);
        const int m = m0 + row, n = n0 + col8;
        *(uint4*)(proj + (size_t)m * 4096 + n) = pv;
        const int r = m & 63, T = m >> 6;
        if (r >= 62 && T + 1 < 264) *(uint4*)(halo + ((size_t)(T + 1) * 3 + (r - 62)) * 4096 + n) = pv;
        if (r == 0 && T >= 1) *(uint4*)(halo + ((size_t)(T - 1) * 3 + 2) * 4096 + n) = pv;
      }
    } else {
#pragma unroll
      for (int k = 0; k < 4; ++k) {
        const int c = tid + 512 * k, row = c >> 3, col8 = (c & 7) * 8;
        float v[8]; ld8(Cs, row, col8, v);
        float* dst = ab + (size_t)(m0 + row) * 64 + col8;
        *(float4*)dst = float4{v[0], v[1], v[2], v[3]};
        *(float4*)(dst + 4) = float4{v[4], v[5], v[6], v[7]};
      }
    }
  }
};

struct EpiGdn1Conv {
  bfu* proj; float* ab; const float* cw;
  DI void operator()(int m0, int n0, int nt, const float* Cs, int tid) const {
    const int b = m0 / TPB, p0 = m0 - b * TPB;
    int vlo, vhi, olo, ohi;
    if (p0 == 0) { vlo = 0; vhi = 256; olo = 0; ohi = 256; }
    else { const int s0 = p0 - CTX; vlo = s0 < 0 ? -s0 : 0; vhi = SEQ - s0 < 256 ? SEQ - s0 : 256; olo = 2; ohi = vhi < 255 ? vhi : 255; }
    if (nt < 32) {
      const int col8 = (tid & 15) * 8, n = n0 + col8;
      float w[4][8];
#pragma unroll
      for (int j = 0; j < 4; ++j) {
        const float4 w0 = *(const float4*)(cw + j * 4096 + n), w1 = *(const float4*)(cw + j * 4096 + n + 4);
        w[j][0] = w0.x; w[j][1] = w0.y; w[j][2] = w0.z; w[j][3] = w0.w; w[j][4] = w1.x; w[j][5] = w1.y; w[j][6] = w1.z; w[j][7] = w1.w;
      }
#pragma unroll
      for (int k = 0; k < 8; ++k) {
        const int row = (tid >> 4) + 32 * k;
        float y[8];
#pragma unroll
        for (int e = 0; e < 8; ++e) y[e] = 0.f;
#pragma unroll
        for (int j = 0; j < 4; ++j) {
          const int rr = row - 2 + j;
          if (rr >= vlo && rr < vhi) {
            float x[8]; ld8(Cs, rr, col8, x);
#pragma unroll
            for (int e = 0; e < 8; ++e) y[e] += w[j][e] * x[e];
          }
        }
        float ss = 0.f;
#pragma unroll
        for (int e = 0; e < 8; ++e) { y[e] = silu_f(y[e]); ss += y[e] * y[e]; }
        if (n0 < 2048) {
#pragma unroll
          for (int off = 8; off >= 1; off >>= 1) ss += __shfl_xor(ss, off);
          float sc = rsqrtf(ss + 1e-6f);
          if (n0 < 1024) sc *= 0.08838834764831845f;
#pragma unroll
          for (int e = 0; e < 8; ++e) y[e] *= sc;
        }
        if (row >= olo && row < ohi) *(uint4*)(proj + (size_t)(m0 + row) * 4096 + n) = pack8(y);
      }
    } else {
#pragma unroll
      for (int k = 0; k < 4; ++k) {
        const int c = tid + 512 * k, row = c >> 3, col8 = (c & 7) * 8;
        if (row >= olo && row < ohi) {
          float v[8]; ld8(Cs, row, col8, v);
          float* dst = ab + (size_t)(m0 + row) * 64 + col8;
          *(float4*)dst = float4{v[0], v[1], v[2], v[3]};
          *(float4*)(dst + 4) = float4{v[4], v[5], v[6], v[7]};
        }
      }
    }
  }
};

struct EpiZGate {
  bfu* a2; const bfu* octx2; const float* ng;
  DI void operator()(int m0, int n0, int nt, const float* Cs, int tid) const {
#pragma unroll
    for (int k = 0; k < 8; ++k) {
      const int c = tid + 512 * k, row = c >> 4, col8 = (c & 15) * 8;
      float v[8], a[8]; ld8(Cs, row, col8, v);
      const int m = m0 + row;
      bfu* ptr = a2 + (size_t)m * 2048 + n0 + col8;
      unpack8(*(const uint4*)ptr, a);
      const int b = m / TPB, p = m - b * TPB;
      if (p < CTX) {
        float a2v[8];
        unpack8(*(const uint4*)(octx2 + (size_t)(b * CTX + p) * 2048 + n0 + col8), a2v);
#pragma unroll
        for (int e = 0; e < 8; ++e) a[e] += a2v[e];
      }
      float ss = 0.f;
#pragma unroll
      for (int e = 0; e < 8; ++e) ss += a[e] * a[e];
#pragma unroll
      for (int off = 8; off >= 1; off >>= 1) ss += __shfl_xor(ss, off);
      const float rstd = rsqrtf(ss * (1.0f / 128.0f) + 1e-6f);
      const float4 g0 = *(const float4*)(ng + col8), g1 = *(const float4*)(ng + col8 + 4);
      const float gv[8] = {g0.x, g0.y, g0.z, g0.w, g1.x, g1.y, g1.z, g1.w};
#pragma unroll
      for (int e = 0; e < 8; ++e) a[e] = bf2f(f2bf(a[e] * rstd * gv[e])) * silu_f(v[e]);
      *(uint4*)ptr = pack8(a);
    }
  }
};

struct EpiResid {
  const float* xsrc; float* xdst; float* ctxres; const float* modl;
  bool colmajor; bool upd_ctx;
  DI void operator()(int m0, int n0, int nt, const float* Cs, int tid) const {
#pragma unroll
    for (int k = 0; k < 8; ++k) {
      const int c = tid + 512 * k, row = c >> 4, col8 = (c & 15) * 8;
      float v[8]; ld8(Cs, row, col8, v);
      const int rr = res_row(m0 + row, colmajor);
      const int n = n0 + col8;
      const float* src; float* dst; int vsel;
      if (rr >= 0) { src = xsrc + (size_t)rr * 1024 + n; dst = xdst + (size_t)rr * 1024 + n; vsel = rr >> 13; }
      else { src = ctxres + (size_t)(-rr - 1) * 1024 + n; dst = ctxres + (size_t)(-rr - 1) * 1024 + n; vsel = 2; }
      if (rr >= 0 || upd_ctx) {
        const float* gp = modl + vsel * 3072 + 2048 + n;
        const float4 g0 = *(const float4*)gp, g1 = *(const float4*)(gp + 4);
        const float4 x0 = *(const float4*)src, x1 = *(const float4*)(src + 4);
        *(float4*)dst = float4{x0.x + g0.x * v[0], x0.y + g0.y * v[1], x0.z + g0.z * v[2], x0.w + g0.w * v[3]};
        *(float4*)(dst + 4) = float4{x1.x + g1.x * v[4], x1.y + g1.y * v[5], x1.z + g1.z * v[6], x1.w + g1.w * v[7]};
      }
    }
  }
};

struct EpiLruIn {
  bfu* xb; bfu* sg;
  DI void operator()(int m0, int n0, int nt, const float* Cs, int tid) const {
#pragma unroll
    for (int k = 0; k < 8; ++k) {
      const int c = tid + 512 * k, row = c >> 4, col8 = (c & 15) * 8;
      float v[8]; ld8(Cs, row, col8, v);
      const int n = n0 + col8;
      if (n < 1024) *(uint4*)(xb + (size_t)(m0 + row) * 1024 + n) = pack8(v);
      else {
#pragma unroll
        for (int e = 0; e < 8; ++e) v[e] = silu_f(v[e]);
        *(uint4*)(sg + (size_t)(m0 + row) * 1024 + n - 1024) = pack8(v);
      }
    }
  }
};

struct EpiLruInConv {
  bfu* xc; bfu* sg; const float* cw; const float* cb;
  DI void operator()(int m0, int n0, int nt, const float* Cs, int tid) const {
    const int b = m0 / TPB, p0 = m0 - b * TPB;
    int vlo, vhi, olo, ohi;
    if (p0 == 0) { vlo = 0; vhi = 256; olo = 0; ohi = 256; }
    else { const int s0 = p0 - CTX; vlo = s0 < 0 ? -s0 : 0; vhi = SEQ - s0 < 256 ? SEQ - s0 : 256; olo = 2; ohi = vhi < 255 ? vhi : 255; }
    const int col8 = (tid & 15) * 8, n = n0 + col8;
    if (n0 < 1024) {
      float w[4][8], bias[8];
#pragma unroll
      for (int j = 0; j < 4; ++j) {
        const float4 w0 = *(const float4*)(cw + j * 1024 + n), w1 = *(const float4*)(cw + j * 1024 + n + 4);
        w[j][0] = w0.x; w[j][1] = w0.y; w[j][2] = w0.z; w[j][3] = w0.w; w[j][4] = w1.x; w[j][5] = w1.y; w[j][6] = w1.z; w[j][7] = w1.w;
      }
      {
        const float4 b0 = *(const float4*)(cb + n), b1 = *(const float4*)(cb + n + 4);
        bias[0] = b0.x; bias[1] = b0.y; bias[2] = b0.z; bias[3] = b0.w; bias[4] = b1.x; bias[5] = b1.y; bias[6] = b1.z; bias[7] = b1.w;
      }
#pragma unroll
      for (int k = 0; k < 8; ++k) {
        const int row = (tid >> 4) + 32 * k;
        if (row >= olo && row < ohi) {
          float y[8];
#pragma unroll
          for (int e = 0; e < 8; ++e) y[e] = bias[e];
#pragma unroll
          for (int j = 0; j < 4; ++j) {
            const int rr = row - 2 + j;
            if (rr >= vlo && rr < vhi) {
              float x[8]; ld8(Cs, rr, col8, x);
#pragma unroll
              for (int e = 0; e < 8; ++e) y[e] += w[j][e] * x[e];
            }
          }
          *(uint4*)(xc + (size_t)(m0 + row) * 1024 + n) = pack8(y);
        }
      }
    } else {
#pragma unroll
      for (int k = 0; k < 8; ++k) {
        const int row = (tid >> 4) + 32 * k;
        if (row >= olo && row < ohi) {
          float v[8]; ld8(Cs, row, col8, v);
#pragma unroll
          for (int e = 0; e < 8; ++e) v[e] = silu_f(v[e]);
          *(uint4*)(sg + (size_t)(m0 + row) * 1024 + n - 1024) = pack8(v);
        }
      }
    }
  }
};

struct EpiLruGate {
  const bfu* xc; bfu* la; bfu* bb; const float* b_r; const float* b_i; const float* spl;
  DI void operator()(int m0, int n0, int nt, const float* Cs, int tid) const {
#pragma unroll
    for (int k = 0; k < 4; ++k) {
      const int c = tid + 512 * k, row = c >> 3, g = (c >> 2) & 1, c4 = c & 3;
      const int grp = (n0 >> 6) + g;
      const int cg8 = grp & 7, d = (grp >> 3) & 1, nblk = grp >> 4;
      const int ch = nblk * 256 + cg8 * 32 + c4 * 8;
      float vr[8], vi[8], xv[8];
      ld8(Cs, row, g * 64 + c4 * 8, vr);
      ld8(Cs, row, g * 64 + 32 + c4 * 8, vi);
      const int m = m0 + row;
      unpack8(*(const uint4*)(xc + (size_t)m * 1024 + ch), xv);
      float lo[8], bo[8];
#pragma unroll
      for (int e = 0; e < 8; ++e) {
        const float r = sigmoid_f(vr[e] + b_r[d * 1024 + ch + e]);
        const float ig = sigmoid_f(vi[e] + b_i[d * 1024 + ch + e]);
        const float loga = -8.0f * r * spl[d * 1024 + ch + e];
        lo[e] = loga;
        bo[e] = __builtin_amdgcn_sqrtf(one_minus_exp(2.0f * loga)) * (ig * xv[e]);
      }
      *(uint4*)(la + ((size_t)m * 2 + d) * 1024 + ch) = pack8(lo);
      *(uint4*)(bb + ((size_t)m * 2 + d) * 1024 + ch) = pack8(bo);
    }
  }
};

DI void mod_phase(const Params& p, float* mod, char* smem) {
  float* sc = (float*)smem;
  float* red = sc + 3 * 1024;
  const int tid = opaque_tid(), lane = tid & 63, wid = tid >> 6;
  for (int i = tid; i < 3 * 1024; i += NTHR) {
    const int v = i >> 10, k = i & 1023;
    const float cv = v < 2 ? p.c[v * 1024 + k] : p.c_ctx[k];
    sc[i] = silu_f(cv);
  }
  __syncthreads();
  for (int t = opaque_bid(); t < 192; t += gridDim.x) {
    const int l = t / 48, n = (t % 48) * 64 + lane;
    const float* w = p.mod_w + (size_t)l * 1024 * 3072 + n;
    float a0 = 0.f, a1 = 0.f, a2 = 0.f;
    for (int k0 = wid * 128; k0 < wid * 128 + 128; k0 += 16) {
      float wv[16];
#pragma unroll
      for (int u = 0; u < 16; ++u) wv[u] = w[(size_t)(k0 + u) * 3072];
#pragma unroll
      for (int u = 0; u < 16; ++u) { a0 += sc[k0 + u] * wv[u]; a1 += sc[1024 + k0 + u] * wv[u]; a2 += sc[2048 + k0 + u] * wv[u]; }
    }
    red[(wid * 3 + 0) * 64 + lane] = a0; red[(wid * 3 + 1) * 64 + lane] = a1; red[(wid * 3 + 2) * 64 + lane] = a2;
    __syncthreads();
    if (tid < 192) {
      const int v = tid >> 6;
      float s = 0.f;
      for (int w8 = 0; w8 < 8; ++w8) s += red[(w8 * 3 + v) * 64 + lane];
      mod[((size_t)l * 3 + v) * 3072 + n] = s + p.mod_b[l * 3072 + n];
    }
    __syncthreads();
  }
}

DI void norm_phase(const float* xsrc, const float* ctxres, const float* ng, const float* modl, bool colmajor, bfu* h) {
  const int tid = opaque_tid(), lane = tid & 63, wid = tid >> 6;
  const int nw = gridDim.x * 8;
  for (int m0 = opaque_bid() * 8 + wid; m0 < M; m0 += 2 * nw) {
    const float* src[2]; int vv[2]; bool ok[2];
    float4 xv[2][4];
#pragma unroll
    for (int u = 0; u < 2; ++u) {
      const int m = m0 + u * nw;
      ok[u] = m < M;
      const int rr = res_row(ok[u] ? m : m0, colmajor);
      if (rr >= 0) { src[u] = xsrc + (size_t)rr * 1024; vv[u] = rr >> 13; } else { src[u] = ctxres + (size_t)(-rr - 1) * 1024; vv[u] = 2; }
#pragma unroll
      for (int i = 0; i < 4; ++i) xv[u][i] = *(const float4*)(src[u] + i * 256 + lane * 4);
    }
#pragma unroll
    for (int u = 0; u < 2; ++u) {
      float ss = 0.f;
#pragma unroll
      for (int i = 0; i < 4; ++i) ss += xv[u][i].x * xv[u][i].x + xv[u][i].y * xv[u][i].y + xv[u][i].z * xv[u][i].z + xv[u][i].w * xv[u][i].w;
      ss = wave_sum(ss);
      const float rstd = rsqrtf(ss * (1.0f / 1024.0f) + 1e-6f);
      const float* shift = modl + vv[u] * 3072;
      const float* scale = shift + 1024;
      if (ok[u]) {
#pragma unroll
        for (int i = 0; i < 4; ++i) {
          const int k = i * 256 + lane * 4;
          const float4 g = *(const float4*)(ng + k), sc = *(const float4*)(scale + k), sh = *(const float4*)(shift + k);
          uint2 ov = {pack2(xv[u][i].x * rstd * g.x * (1.f + sc.x) + sh.x, xv[u][i].y * rstd * g.y * (1.f + sc.y) + sh.y),
                      pack2(xv[u][i].z * rstd * g.z * (1.f + sc.z) + sh.z, xv[u][i].w * rstd * g.w * (1.f + sc.w) + sh.w)};
          *(uint2*)(h + (size_t)(m0 + u * nw) * 1024 + k) = ov;
        }
      }
    }
  }
}

DI void final_norm_phase(float* x, const float* fg) {
  const int lane = opaque_tid() & 63, wid = opaque_tid() >> 6;
  for (int r = opaque_bid() * 8 + wid; r < 2 * SEQ; r += gridDim.x * 8) {
    float* src = x + (size_t)r * 1024;
    float4 xv[4];
    float ss = 0.f;
#pragma unroll
    for (int i = 0; i < 4; ++i) {
      xv[i] = *(const float4*)(src + i * 256 + lane * 4);
      ss += xv[i].x * xv[i].x + xv[i].y * xv[i].y + xv[i].z * xv[i].z + xv[i].w * xv[i].w;
    }
    ss = wave_sum(ss);
    const float rstd = rsqrtf(ss * (1.0f / 1024.0f) + 1e-6f);
#pragma unroll
    for (int i = 0; i < 4; ++i) {
      const int k = i * 256 + lane * 4;
      const float4 g = *(const float4*)(fg + k);
      float4 o = {xv[i].x * rstd * g.x, xv[i].y * rstd * g.y, xv[i].z * rstd * g.z, xv[i].w * rstd * g.w};
      *(float4*)(src + k) = o;
    }
  }
}

DI void ld2(const bfu* ptr, float& a, float& b) {
  const uint32_t v = *(const uint32_t*)ptr;
  a = __uint_as_float(v << 16);
  b = __uint_as_float(v & 0xffff0000u);
}

DI void gdn_conv_phase(bfu* proj, const bfu* halo, const float* cw) {
  const int lane = opaque_tid() & 63, wid = opaque_tid() >> 6;
  for (int task = opaque_bid() * 8 + wid; task < 264 * 32; task += gridDim.x * 8) {
    const int T = task >> 5, u_ = task & 31;
    const int ch = u_ * 128 + lane * 2;
    const int p0 = (T % NCH) * 64;
    const bool sstart = (p0 == 0 || p0 == CTX), send = (p0 + 64 == CTX || p0 + 64 == TPB);
    float w00 = cw[0 * 4096 + ch], w01 = cw[0 * 4096 + ch + 1];
    float w10 = cw[1 * 4096 + ch], w11 = cw[1 * 4096 + ch + 1];
    float w20 = cw[2 * 4096 + ch], w21 = cw[2 * 4096 + ch + 1];
    float w30 = cw[3 * 4096 + ch], w31 = cw[3 * 4096 + ch + 1];
    float xm2a = 0.f, xm2b = 0.f, xm1a = 0.f, xm1b = 0.f, x0a, x0b, xp1a, xp1b;
    if (!sstart) { ld2(halo + ((size_t)T * 3 + 0) * 4096 + ch, xm2a, xm2b); ld2(halo + ((size_t)T * 3 + 1) * 4096 + ch, xm1a, xm1b); }
    bfu* row = proj + (size_t)T * 64 * 4096 + ch;
    ld2(row, x0a, x0b);
    for (int t8 = 0; t8 < 64; t8 += 16) {
      uint32_t nx[16];
#pragma unroll
      for (int u = 0; u < 16; ++u) {
        const int tt = t8 + u;
        if (tt < 63) nx[u] = *(const uint32_t*)(row + (size_t)(tt + 1) * 4096);
        else nx[u] = send ? 0u : *(const uint32_t*)(halo + ((size_t)T * 3 + 2) * 4096 + ch);
      }
#pragma unroll
      for (int u = 0; u < 16; ++u) {
        const int tt = t8 + u;
        xp1a = __uint_as_float(nx[u] << 16); xp1b = __uint_as_float(nx[u] & 0xffff0000u);
        float y0 = w00 * xm2a + w10 * xm1a + w20 * x0a + w30 * xp1a;
        float y1 = w01 * xm2b + w11 * xm1b + w21 * x0b + w31 * xp1b;
        y0 = silu_f(y0); y1 = silu_f(y1);
        if (u_ < 16) {
          const float ss = wave_sum(y0 * y0 + y1 * y1);
          float sc = rsqrtf(ss + 1e-6f);
          if (u_ < 8) sc *= 0.08838834764831845f;
          y0 *= sc; y1 *= sc;
        }
        *(uint32_t*)(row + (size_t)tt * 4096) = pack2(y0, y1);
        xm2a = xm1a; xm2b = xm1b; xm1a = x0a; xm1b = x0b; x0a = xp1a; x0b = xp1b;
      }
    }
  }
}

using f32x16 = __attribute__((ext_vector_type(16))) float;
#define MFMA32(a, b, c) __builtin_amdgcn_mfma_f32_32x32x16_bf16((a), (b), (c), 0, 0, 0)
constexpr int SEG_STRIDE = 28800;
constexpr int WF_OFF = 0, KDF_OFF = 8192, QKF_OFF = 16384, UF_OFF = 20480, EG_OFF = 28672;
constexpr int SEG_STEPS = 8;
constexpr int PREP_HALF_LDS = 75776;

DI bf16x8 frag8(const bfu* p) {
  const uint2 a = *(const uint2*)p, b = *(const uint2*)(p + 4);
  uint4 v = {a.x, a.y, b.x, b.y};
  return __builtin_bit_cast(bf16x8, v);
}
DI int crow(int i, int h) { return (i & 3) + 8 * (i >> 2) + 4 * h; }

DI void gdn_prep(const bfu* __restrict__ proj, const float* __restrict__ gab, const float* __restrict__ a_log,
                 const float* __restrict__ dt_bias, bfu* __restrict__ seg, float* __restrict__ glbuf, int s0, int s1, char* smem,
                 unsigned* prog, unsigned need) {
  const int ntasks = 64 * (s1 - s0);
  for (int pt = opaque_bid(); pt * 2 < ntasks; pt += gridDim.x) {
    const int tid = opaque_tid(), half = tid >> 8, ht = tid & 255, hw = ht >> 6, lane = tid & 63;
    const int r = lane & 31, h = lane >> 5;
    char* base = smem + half * PREP_HALF_LDS;
    bfu* qs = (bfu*)base;
    bfu* ks = qs + 64 * 136;
    bfu* kT = ks + 64 * 136;
    bfu* vT = kT + 128 * 68;
    float* gs = (float*)(vT + 128 * 68);
    float* Lm = (float*)qs;
    bfu* T1 = ks;
    bfu* T2 = ks + 64 * 68;
    const int tsk0 = pt * 2 + half;
    const bool valid = tsk0 < ntasks;
    const int tsk = valid ? tsk0 : ntasks - 1;
    const int slot = tsk >> 6, chain = tsk & 63, step = s0 + slot;
    const int b = chain >> 5, dir = (chain >> 4) & 1, hh = chain & 15, qh = hh >> 1;
    const int m0 = chain_row(b, dir, step * 64);
    const int sgn = dir == 0 ? 1 : -1;
    bfu* segp = seg + ((size_t)slot * 64 + chain) * SEG_STRIDE;
    if (need != 0u) {
      if (ht == 0) { unsigned sp = 0; while (xb_ld(prog + 8 * chain) < need) { __builtin_amdgcn_s_sleep(1); if (++sp > (1u << 20)) break; } }
      __syncthreads();
    }
    if (hw == 0) {
      const int m = m0 + sgn * lane;
      const float rawg = gab[(size_t)m * 64 + dir * 32 + hh], rawb = gab[(size_t)m * 64 + dir * 32 + 16 + hh];
      const float g = -__expf(a_log[dir * 16 + hh]) * softplus_f(rawg + dt_bias[dir * 16 + hh]);
      float cs = g;
#pragma unroll
      for (int o = 1; o < 64; o <<= 1) { const float t = __shfl_up(cs, o); if (lane >= o) cs += t; }
      const float gl = __shfl(cs, 63);
      gs[lane] = cs; gs[64 + lane] = sigmoid_f(rawb); gs[128 + lane] = __expf(cs); gs[192 + lane] = __expf(gl - cs);
      if (lane == 0 && valid) glbuf[chain * NCH + step] = __expf(gl);
      if (valid) ((float*)(segp + EG_OFF))[lane] = __expf(cs);
    }
#pragma unroll
    for (int it = 0; it < 4; ++it) {
      const int c = (ht & 15) + 16 * hw, col8 = (((ht >> 4) & 3) + 4 * it) * 8;
      const bfu* rowp = proj + (size_t)(m0 + sgn * c) * 4096;
      const uint4 qv = *(const uint4*)(rowp + qh * 128 + col8);
      const uint4 kv = *(const uint4*)(rowp + 1024 + qh * 128 + col8);
      const uint4 vv = *(const uint4*)(rowp + 2048 + hh * 128 + col8);
      *(uint4*)(qs + c * 136 + col8) = qv;
      *(uint4*)(ks + c * 136 + col8) = kv;
      const uint32_t kw[4] = {kv.x, kv.y, kv.z, kv.w}, vw[4] = {vv.x, vv.y, vv.z, vv.w};
#pragma unroll
      for (int i = 0; i < 4; ++i) {
        kT[(col8 + 2 * i) * 68 + c] = (bfu)(kw[i] & 0xffffu);
        kT[(col8 + 2 * i + 1) * 68 + c] = (bfu)(kw[i] >> 16);
        vT[(col8 + 2 * i) * 68 + c] = (bfu)(vw[i] & 0xffffu);
        vT[(col8 + 2 * i + 1) * 68 + c] = (bfu)(vw[i] >> 16);
      }
    }
    __syncthreads();
    const int ti = hw >> 1, tj = hw & 1;
    f32x16 kkacc, qkacc;
#pragma unroll
    for (int i = 0; i < 16; ++i) { kkacc[i] = 0.f; qkacc[i] = 0.f; }
#pragma unroll
    for (int k8 = 0; k8 < 8; ++k8) {
      const bf16x8 a = *(const bf16x8*)(ks + (32 * ti + r) * 136 + 16 * k8 + 8 * h);
      const bf16x8 bk = *(const bf16x8*)(ks + (32 * tj + r) * 136 + 16 * k8 + 8 * h);
      const bf16x8 bq = *(const bf16x8*)(qs + (32 * tj + r) * 136 + 16 * k8 + 8 * h);
      kkacc = MFMA32(a, bk, kkacc);
      qkacc = MFMA32(a, bq, qkacc);
    }
    __syncthreads();
#pragma unroll
    for (int i = 0; i < 16; ++i) {
      const int c = 32 * ti + crow(i, h), sidx = 32 * tj + r;
      Lm[c * 64 + sidx] = (sidx < c) ? gs[64 + c] * kkacc[i] * __expf(gs[c] - gs[sidx]) : 0.f;
    }
#pragma unroll
    for (int q = 0; q < 4; ++q) {
      const int c = 32 * tj + r;
      float vals[4];
#pragma unroll
      for (int t = 0; t < 4; ++t) {
        const int sidx = 32 * ti + 8 * q + 4 * h + t;
        vals[t] = (sidx <= c) ? qkacc[4 * q + t] * __expf(gs[c] - gs[sidx]) : 0.f;
      }
      const int k4 = 2 * ti + (q >> 1), hp = q & 1;
      uint2 ov = {pack2(vals[0], vals[1]), pack2(vals[2], vals[3])};
      if (valid) *(uint2*)(segp + QKF_OFF + ((tj * 4 + k4) * 64 + hp * 32 + r) * 8 + 4 * h) = ov;
    }
    __syncthreads();
    bfu* TB = (bfu*)(gs + 256);
    bfu* TA = TB + 32 * 40;
    const int wa = half, wb = half ^ 1;
    if (hw == wa || hw == wb) {
      const int ob = (hw == wa) ? 0 : 32;
      f32x2_t t2[16];
#pragma unroll
      for (int i = 0; i < 16; ++i) t2[i] = f32x2_t{0.f, 0.f};
      int r_o = r;
      asm volatile("" : "+v"(r_o));
#pragma unroll
      for (int i = 0; i < 32; ++i) {
        f32x2_t a0 = {0.f, 0.f}, a1 = {0.f, 0.f};
#pragma unroll
        for (int q = 0; q < (i + 3) / 4; ++q) {
          const float4 l4 = *(const float4*)(Lm + (ob + i) * 64 + ob + 4 * q);
          a0 = __builtin_elementwise_fma(f32x2_t{l4.x, l4.y}, t2[2 * q], a0);
          a1 = __builtin_elementwise_fma(f32x2_t{l4.z, l4.w}, t2[2 * q + 1], a1);
        }
        const float acc = ((i == r_o) ? 1.f : 0.f) - ((a0[0] + a0[1]) + (a1[0] + a1[1]));
        t2[i >> 1][i & 1] = acc;
        if ((i & 15) == 15) __builtin_amdgcn_sched_barrier(0);
      }
      const float s2 = gs[64 + ob + r], s1v = s2 * gs[128 + ob + r];
      if (h == 0) {
#pragma unroll
        for (int i = 0; i < 32; ++i) {
          const uint32_t pk = pack2(t2[i >> 1][i & 1] * s1v, t2[i >> 1][i & 1] * s2);
          T1[(ob + i) * 68 + ob + r] = (bfu)(pk & 0xffffu);
          T2[(ob + i) * 68 + ob + r] = (bfu)(pk >> 16);
        }
      } else if (hw == wa) {
#pragma unroll
        for (int g = 0; g < 4; ++g) {
          uint4 v = {pack2(t2[4 * g][0], t2[4 * g][1]), pack2(t2[4 * g + 1][0], t2[4 * g + 1][1]),
                     pack2(t2[4 * g + 2][0], t2[4 * g + 2][1]), pack2(t2[4 * g + 3][0], t2[4 * g + 3][1])};
          *(uint4*)(TB + r * 40 + 8 * g) = v;
        }
      } else {
#pragma unroll
        for (int i = 0; i < 32; ++i) {
          TA[i * 40 + r] = f2bf(t2[i >> 1][i & 1]);
          T1[i * 68 + 32 + r] = 0;
          T2[i * 68 + 32 + r] = 0;
        }
      }
    } else {
      for (int idx = (hw - 2) * 64 + lane; idx < 1024; idx += 128) {
        const int l_ = idx & 63, k4 = (idx >> 6) & 3, dkb = idx >> 8;
        const int dk = 32 * dkb + (l_ & 31), cb = 16 * k4 + 8 * (l_ >> 5);
        const uint2 v0 = *(const uint2*)(kT + dk * 68 + cb), v1 = *(const uint2*)(kT + dk * 68 + cb + 4);
        const float* ek = gs + 192 + cb;
        uint4 ov;
        ov.x = pack2(__uint_as_float(v0.x << 16) * ek[0], __uint_as_float(v0.x & 0xffff0000u) * ek[1]);
        ov.y = pack2(__uint_as_float(v0.y << 16) * ek[2], __uint_as_float(v0.y & 0xffff0000u) * ek[3]);
        ov.z = pack2(__uint_as_float(v1.x << 16) * ek[4], __uint_as_float(v1.x & 0xffff0000u) * ek[5]);
        ov.w = pack2(__uint_as_float(v1.y << 16) * ek[6], __uint_as_float(v1.y & 0xffff0000u) * ek[7]);
        if (valid) *(uint4*)(segp + KDF_OFF + idx * 8) = ov;
      }
    }
    __syncthreads();
    if (hw == wa) {
      f32x16 X, Y;
#pragma unroll
      for (int i = 0; i < 16; ++i) { X[i] = 0.f; Y[i] = 0.f; }
#pragma unroll
      for (int k2 = 0; k2 < 2; ++k2) {
        const float4 l0 = *(const float4*)(Lm + (32 + r) * 64 + 16 * k2 + 8 * h), l1 = *(const float4*)(Lm + (32 + r) * 64 + 16 * k2 + 8 * h + 4);
        const uint4 av = {pack2(l0.x, l0.y), pack2(l0.z, l0.w), pack2(l1.x, l1.y), pack2(l1.z, l1.w)};
        const bf16x8 bt = *(const bf16x8*)(TB + r * 40 + 16 * k2 + 8 * h);
        X = MFMA32(__builtin_bit_cast(bf16x8, av), bt, X);
      }
#pragma unroll
      for (int s2i = 0; s2i < 2; ++s2i) {
        const uint4 xv = {pack2(X[8 * s2i], X[8 * s2i + 1]), pack2(X[8 * s2i + 2], X[8 * s2i + 3]),
                          pack2(X[8 * s2i + 4], X[8 * s2i + 5]), pack2(X[8 * s2i + 6], X[8 * s2i + 7])};
        const uint2 a_lo = *(const uint2*)(TA + r * 40 + 16 * s2i + 4 * h), a_hi = *(const uint2*)(TA + r * 40 + 16 * s2i + 8 + 4 * h);
        const uint4 av = {a_lo.x, a_lo.y, a_hi.x, a_hi.y};
        Y = MFMA32(__builtin_bit_cast(bf16x8, av), __builtin_bit_cast(bf16x8, xv), Y);
      }
      const float c2 = gs[64 + r], c1 = c2 * gs[128 + r];
#pragma unroll
      for (int i = 0; i < 16; ++i) {
        const uint32_t pk = pack2(-Y[i] * c1, -Y[i] * c2);
        T1[(32 + crow(i, h)) * 68 + r] = (bfu)(pk & 0xffffu);
        T2[(32 + crow(i, h)) * 68 + r] = (bfu)(pk >> 16);
      }
    }
    __syncthreads();
    {
      f32x16 wa0, wa1;
#pragma unroll
      for (int i = 0; i < 16; ++i) { wa0[i] = 0.f; wa1[i] = 0.f; }
#pragma unroll
      for (int k4 = 0; k4 < 4; ++k4) {
        const int ko = 16 * k4 + 8 * h;
        const bf16x8 ak = frag8(kT + (32 * hw + r) * 68 + ko);
        const bf16x8 bt0 = frag8(T1 + r * 68 + ko), bt1 = frag8(T1 + (32 + r) * 68 + ko);
        wa0 = MFMA32(ak, bt0, wa0);
        wa1 = MFMA32(ak, bt1, wa1);
      }
      if (valid) {
#pragma unroll
        for (int q = 0; q < 4; ++q) {
          const int k8 = 2 * hw + (q >> 1), hp = q & 1;
          uint2 o0 = {pack2(-wa0[4 * q], -wa0[4 * q + 1]), pack2(-wa0[4 * q + 2], -wa0[4 * q + 3])};
          uint2 o1 = {pack2(-wa1[4 * q], -wa1[4 * q + 1]), pack2(-wa1[4 * q + 2], -wa1[4 * q + 3])};
          *(uint2*)(segp + WF_OFF + ((0 * 8 + k8) * 64 + hp * 32 + r) * 8 + 4 * h) = o0;
          *(uint2*)(segp + WF_OFF + ((1 * 8 + k8) * 64 + hp * 32 + r) * 8 + 4 * h) = o1;
        }
      }
    }
    {
      f32x16 ua0, ua1;
#pragma unroll
      for (int i = 0; i < 16; ++i) { ua0[i] = 0.f; ua1[i] = 0.f; }
#pragma unroll
      for (int k4 = 0; k4 < 4; ++k4) {
        const int ko = 16 * k4 + 8 * h;
        const bf16x8 at0 = frag8(T2 + r * 68 + ko), at1 = frag8(T2 + (32 + r) * 68 + ko);
        const bf16x8 bv = frag8(vT + (32 * hw + r) * 68 + ko);
        ua0 = MFMA32(at0, bv, ua0);
        ua1 = MFMA32(at1, bv, ua1);
      }
      if (valid) {
        uint4 u;
        bfu* up0 = segp + UF_OFF + ((hw * 2 + 0) * 64 + lane) * 16;
        bfu* up1 = segp + UF_OFF + ((hw * 2 + 1) * 64 + lane) * 16;
        u = {pack2(ua0[0], ua0[1]), pack2(ua0[2], ua0[3]), pack2(ua0[4], ua0[5]), pack2(ua0[6], ua0[7])}; *(uint4*)up0 = u;
        u = {pack2(ua0[8], ua0[9]), pack2(ua0[10], ua0[11]), pack2(ua0[12], ua0[13]), pack2(ua0[14], ua0[15])}; *(uint4*)(up0 + 8) = u;
        u = {pack2(ua1[0], ua1[1]), pack2(ua1[2], ua1[3]), pack2(ua1[4], ua1[5]), pack2(ua1[6], ua1[7])}; *(uint4*)up1 = u;
        u = {pack2(ua1[8], ua1[9]), pack2(ua1[10], ua1[11]), pack2(ua1[12], ua1[13]), pack2(ua1[14], ua1[15])}; *(uint4*)(up1 + 8) = u;
      }
    }
    __syncthreads();
  }
}

struct ScanOps { bf16x8 af[8]; bf16x8 b4[4]; uint4 u0, u1; float gl; float egv; };
DI void scan_load(ScanOps& q, const bfu* __restrict__ sp, const float* __restrict__ glbuf, const bfu* __restrict__ proj, int w, int lane, int sl,
                  int chain, int step) {
  if (w < 4) {
    const int mb = w & 1;
    if (w < 2) {
      const bfu* ap = sp + WF_OFF + (mb * 8 * 64 + lane) * 8;
#pragma unroll
      for (int k8 = 0; k8 < 8; ++k8) q.af[k8] = *(const bf16x8*)(ap + k8 * 512);
      const bfu* up = sp + UF_OFF + ((sl * 2 + mb) * 64 + lane) * 16;
      q.u0 = *(const uint4*)up; q.u1 = *(const uint4*)(up + 8);
    } else {
      const int b = chain >> 5, dir = (chain >> 4) & 1, qh = (chain & 15) >> 1;
      const int m = chain_row(b, dir, step * 64 + 32 * mb + (lane & 31));
      const bfu* ap = proj + (size_t)m * 4096 + qh * 128 + 8 * (lane >> 5);
#pragma unroll
      for (int k8 = 0; k8 < 8; ++k8) q.af[k8] = *(const bf16x8*)(ap + 16 * k8);
      q.egv = ((const float*)(sp + EG_OFF))[lane];
      const bfu* qp = sp + QKF_OFF + (mb * 4 * 64 + lane) * 8;
#pragma unroll
      for (int k4 = 0; k4 < 4; ++k4) q.b4[k4] = *(const bf16x8*)(qp + k4 * 512);
    }
  } else {
    const bfu* kp = sp + KDF_OFF + ((w - 4) * 4 * 64 + lane) * 8;
#pragma unroll
    for (int k4 = 0; k4 < 4; ++k4) q.b4[k4] = *(const bf16x8*)(kp + k4 * 512);
    q.gl = glbuf[chain * NCH + step];
  }
}

DI bfu* o_piece_ptr(bfu* o, bfu* octx2, int b, int dir, int hh, int sl, int step, int c, int piece) {
  const int m = chain_row(b, dir, step * 64 + c);
  const int col = hh * 128 + 32 * sl + piece * 8;
  if (step < 4 && dir == 1) return octx2 + (size_t)(b * CTX + (m - b * TPB)) * 2048 + col;
  return o + (size_t)m * 2048 + col;
}

DI void gdn_scan_seg(const bfu* __restrict__ seg, const float* __restrict__ glbuf, const bfu* __restrict__ proj, int s0, int s1, float* sstate,
                     bfu* o, bfu* octx2, char* smem) {
  bfu* Sb = (bfu*)smem;
  bfu* Vn = Sb + 32 * 136;
  bfu* Ot = Vn + 32 * 68;
  float* Eg = (float*)(Ot + 2 * 32 * 40);
  const int tid = opaque_tid(), w = tid >> 6, lane = tid & 63, r = lane & 31, h = lane >> 5;
  const int bid = opaque_bid();
  const int chain = (bid & 7) * 8 + (bid >> 5), sl = (bid >> 3) & 3;
  const int b = chain >> 5, dir = (chain >> 4) & 1, hh = chain & 15;
  f32x16 Sacc;
  float* sst = sstate + ((size_t)bid * 256 + (tid & 255)) * 16;
  if (s0 == 0) {
#pragma unroll
    for (int i = 0; i < 16; ++i) Sacc[i] = 0.f;
  } else if (w >= 4) {
#pragma unroll
    for (int i = 0; i < 4; ++i) { const float4 v = *(const float4*)(sst + 4 * i); Sacc[4 * i] = v.x; Sacc[4 * i + 1] = v.y; Sacc[4 * i + 2] = v.z; Sacc[4 * i + 3] = v.w; }
  }
  ScanOps cur;
  scan_load(cur, seg + (size_t)chain * SEG_STRIDE, glbuf, proj, w, lane, sl, chain, s0);
  for (int step = s0; step < s1; ++step) {
    ScanOps nxt;
    if (step + 1 < s1) scan_load(nxt, seg + ((size_t)(step + 1 - s0) * 64 + chain) * SEG_STRIDE, glbuf, proj, w, lane, sl, chain, step + 1);
    uint4 oldo0 = {0, 0, 0, 0}, oldo1 = {0, 0, 0, 0};
    if (step >= 68 && (w == 2 || w == 3)) {
      oldo0 = *(const uint4*)o_piece_ptr(o, octx2, b, dir, hh, sl, step, 32 * (w - 2) + (lane >> 2), lane & 3);
      oldo1 = *(const uint4*)o_piece_ptr(o, octx2, b, dir, hh, sl, step, 32 * (w - 2) + (lane >> 2) + 16, lane & 3);
    }
    if (w == 2) Eg[lane] = cur.egv;
    if (w >= 4) {
#pragma unroll
      for (int q = 0; q < 4; ++q) {
        uint2 ov = {pack2(Sacc[4 * q], Sacc[4 * q + 1]), pack2(Sacc[4 * q + 2], Sacc[4 * q + 3])};
        *(uint2*)(Sb + r * 136 + 32 * (w - 4) + 8 * q + 4 * h) = ov;
      }
    }
    __syncthreads();
    f32x16 acc;
    if (w < 4) {
      if (w < 2) {
        const uint32_t uw[8] = {cur.u0.x, cur.u0.y, cur.u0.z, cur.u0.w, cur.u1.x, cur.u1.y, cur.u1.z, cur.u1.w};
#pragma unroll
        for (int i = 0; i < 8; ++i) { acc[2 * i] = __uint_as_float(uw[i] << 16); acc[2 * i + 1] = __uint_as_float(uw[i] & 0xffff0000u); }
      } else {
#pragma unroll
        for (int i = 0; i < 16; ++i) acc[i] = 0.f;
      }
#pragma unroll
      for (int k8 = 0; k8 < 8; ++k8) {
        const bf16x8 bs = *(const bf16x8*)(Sb + r * 136 + 16 * k8 + 8 * h);
        acc = MFMA32(cur.af[k8], bs, acc);
      }
      if (w < 2) {
#pragma unroll
        for (int q = 0; q < 4; ++q) {
          uint2 ov = {pack2(acc[4 * q], acc[4 * q + 1]), pack2(acc[4 * q + 2], acc[4 * q + 3])};
          *(uint2*)(Vn + r * 68 + 32 * w + 8 * q + 4 * h) = ov;
        }
      } else {
#pragma unroll
        for (int q = 0; q < 4; ++q) {
          const float4 e4 = *(const float4*)(Eg + 32 * (w & 1) + 8 * q + 4 * h);
          acc[4 * q] *= e4.x; acc[4 * q + 1] *= e4.y; acc[4 * q + 2] *= e4.z; acc[4 * q + 3] *= e4.w;
        }
      }
    }
    __syncthreads();
    if (w >= 2) {
      bf16x8 bv[4];
#pragma unroll
      for (int k4 = 0; k4 < 4; ++k4) bv[k4] = frag8(Vn + r * 68 + 16 * k4 + 8 * h);
      if (w < 4) {
#pragma unroll
        for (int k4 = 0; k4 < 4; ++k4) acc = MFMA32(cur.b4[k4], bv[k4], acc);
        bfu* ot = Ot + (w - 2) * 32 * 40;
#pragma unroll
        for (int i = 0; i < 16; ++i) ot[crow(i, h) * 40 + r] = f2bf(acc[i]);
        __builtin_amdgcn_s_waitcnt(0xc07f);
        __builtin_amdgcn_wave_barrier();
#pragma unroll
        for (int u = 0; u < 2; ++u) {
          const int cl = (lane >> 2) + 16 * u, piece = lane & 3;
          const uint4 nv = *(const uint4*)(ot + cl * 40 + piece * 8);
          bfu* gp = o_piece_ptr(o, octx2, b, dir, hh, sl, step, 32 * (w - 2) + cl, piece);
          if (step < 68) *(uint4*)gp = nv;
          else {
            const uint4 ov = u == 0 ? oldo0 : oldo1;
            uint4 rv;
            rv.x = pack2(__uint_as_float(ov.x << 16) + __uint_as_float(nv.x << 16), __uint_as_float(ov.x & 0xffff0000u) + __uint_as_float(nv.x & 0xffff0000u));
            rv.y = pack2(__uint_as_float(ov.y << 16) + __uint_as_float(nv.y << 16), __uint_as_float(ov.y & 0xffff0000u) + __uint_as_float(nv.y & 0xffff0000u));
            rv.z = pack2(__uint_as_float(ov.z << 16) + __uint_as_float(nv.z << 16), __uint_as_float(ov.z & 0xffff0000u) + __uint_as_float(nv.z & 0xffff0000u));
            rv.w = pack2(__uint_as_float(ov.w << 16) + __uint_as_float(nv.w << 16), __uint_as_float(ov.w & 0xffff0000u) + __uint_as_float(nv.w & 0xffff0000u));
            *(uint4*)gp = rv;
          }
        }
      } else {
#pragma unroll
        for (int i = 0; i < 16; ++i) Sacc[i] *= cur.gl;
#pragma unroll
        for (int k4 = 0; k4 < 4; ++k4) Sacc = MFMA32(cur.b4[k4], bv[k4], Sacc);
      }
    }
    cur = nxt;
  }
  if (w >= 4) {
#pragma unroll
    for (int i = 0; i < 4; ++i) { float4 v = {Sacc[4 * i], Sacc[4 * i + 1], Sacc[4 * i + 2], Sacc[4 * i + 3]}; *(float4*)(sst + 4 * i) = v; }
  }
}

DI void gdn_chunked(const bfu* proj, const float* gab, const float* a_log, const float* dt_bias, bfu* seg, float* glbuf, bfu* o,
                    bfu* octx2, char* smem, const XcdBarrier& gbar, unsigned& lb_count) {
  float* sstate = glbuf + 16384;
  unsigned* prog = gbar.bar + 3520;
  const int bid = opaque_bid();
  const int my_chain = (bid & 7) * 8 + (bid >> 5);
  for (int s0 = 0; s0 < NCH;) {
    const int lim = s0 < 68 ? 68 : NCH;
    const int s1 = s0 + SEG_STEPS < lim ? s0 + SEG_STEPS : lim;
    gdn_prep(proj, gab, a_log, dt_bias, seg, glbuf, s0, s1, smem, prog, 4u * lb_count);
    xcd_barrier(gbar);
    gdn_scan_seg(seg, glbuf, proj, s0, s1, sstate, o, octx2, smem);
    asm volatile("s_waitcnt vmcnt(0)" ::: "memory");
    __syncthreads();
    if (opaque_tid() == 0) xb_add(prog + 8 * my_chain, 1u);
    lb_count += 1u;
    if (s1 >= NCH) xcd_barrier(gbar);
    s0 = s1;
  }
}

DI void gdn_post_phase(bfu* o, const bfu* octx2, const float* ng) {
  const int tid = opaque_tid(), lane = tid & 63, wid = tid >> 6;
  const int hl = lane >> 5, l32 = lane & 31;
  const float4 g = *(const float4*)(ng + l32 * 4);
  for (int m = opaque_bid() * 8 + wid; m < M; m += gridDim.x * 8) {
    const int b = m / TPB, p = m - b * TPB;
    bfu* orow = o + (size_t)m * 2048 + hl * 128 + l32 * 4;
    uint2 v[8], v2[8];
#pragma unroll
    for (int it = 0; it < 8; ++it) v[it] = *(const uint2*)(orow + it * 256);
    if (p < CTX) {
      const bfu* crow_ = octx2 + (size_t)(b * CTX + p) * 2048 + hl * 128 + l32 * 4;
#pragma unroll
      for (int it = 0; it < 8; ++it) v2[it] = *(const uint2*)(crow_ + it * 256);
    }
#pragma unroll
    for (int it = 0; it < 8; ++it) {
      float f0 = __uint_as_float(v[it].x << 16), f1 = __uint_as_float(v[it].x & 0xffff0000u);
      float f2 = __uint_as_float(v[it].y << 16), f3 = __uint_as_float(v[it].y & 0xffff0000u);
      if (p < CTX) {
        f0 += __uint_as_float(v2[it].x << 16); f1 += __uint_as_float(v2[it].x & 0xffff0000u);
        f2 += __uint_as_float(v2[it].y << 16); f3 += __uint_as_float(v2[it].y & 0xffff0000u);
      }
      float ss = f0 * f0 + f1 * f1 + f2 * f2 + f3 * f3;
#pragma unroll
      for (int off = 16; off >= 1; off >>= 1) ss += __shfl_xor(ss, off);
      const float rstd = rsqrtf(ss * (1.0f / 128.0f) + 1e-6f);
      uint2 ov = {pack2(f0 * rstd * g.x, f1 * rstd * g.y), pack2(f2 * rstd * g.z, f3 * rstd * g.w)};
      *(uint2*)(orow + it * 256) = ov;
    }
  }
}

DI void lru_conv_phase(const bfu* xb, const float* cw, const float* cb, bfu* xc) {
  const int total = M * 128;
  for (int it = opaque_bid() * NTHR + opaque_tid(); it < total; it += gridDim.x * NTHR) {
    const int m = it >> 7, c8 = (it & 127) * 8;
    const int b = m / TPB, p = m - b * TPB;
    const int lo = p < CTX ? 0 : CTX, hi = p < CTX ? CTX : TPB;
    const float4 cb0 = *(const float4*)(cb + c8), cb1 = *(const float4*)(cb + c8 + 4);
    float a0 = cb0.x, a1 = cb0.y, a2 = cb0.z, a3 = cb0.w, a4 = cb1.x, a5 = cb1.y, a6 = cb1.z, a7 = cb1.w;
#pragma unroll
    for (int j = 0; j < 4; ++j) {
      const int pp = p - 2 + j;
      if (pp >= lo && pp < hi) {
        const uint4 v = *(const uint4*)(xb + (size_t)(m - 2 + j) * 1024 + c8);
        const float4 w0 = *(const float4*)(cw + j * 1024 + c8), w1 = *(const float4*)(cw + j * 1024 + c8 + 4);
        a0 += w0.x * __uint_as_float(v.x << 16); a1 += w0.y * __uint_as_float(v.x & 0xffff0000u);
        a2 += w0.z * __uint_as_float(v.y << 16); a3 += w0.w * __uint_as_float(v.y & 0xffff0000u);
        a4 += w1.x * __uint_as_float(v.z << 16); a5 += w1.y * __uint_as_float(v.z & 0xffff0000u);
        a6 += w1.z * __uint_as_float(v.w << 16); a7 += w1.w * __uint_as_float(v.w & 0xffff0000u);
      }
    }
    uint4 o;
    o.x = (uint32_t)f2bf(a0) | ((uint32_t)f2bf(a1) << 16);
    o.y = (uint32_t)f2bf(a2) | ((uint32_t)f2bf(a3) << 16);
    o.z = (uint32_t)f2bf(a4) | ((uint32_t)f2bf(a5) << 16);
    o.w = (uint32_t)f2bf(a6) | ((uint32_t)f2bf(a7) << 16);
    *(uint4*)(xc + (size_t)m * 1024 + c8) = o;
  }
}

DI void lru_scan1(const bfu* la, const bfu* bb, float* cp, float* chh) {
  const int total = 2 * 2 * NCH * 512;
  for (int e = opaque_bid() * NTHR + opaque_tid(); e < total; e += gridDim.x * NTHR) {
    const int ch = (e & 511) * 2, r = e >> 9;
    const int j = r % NCH, bd = r / NCH, d = bd & 1, b = bd >> 1;
    float P0 = 1.f, P1 = 1.f, H0 = 0.f, H1 = 0.f;
    const int m0 = chain_row(b, d, j * 64);
    const long stride = d == 0 ? 2048 : -2048;
    const bfu* lp = la + ((size_t)m0 * 2 + d) * 1024 + ch;
    const bfu* bp = bb + ((size_t)m0 * 2 + d) * 1024 + ch;
    for (int t8 = 0; t8 < 64; t8 += 16) {
      uint32_t lv[16], bv[16];
#pragma unroll
      for (int u = 0; u < 16; ++u) { lv[u] = *(const uint32_t*)(lp + (t8 + u) * stride); bv[u] = *(const uint32_t*)(bp + (t8 + u) * stride); }
#pragma unroll
      for (int u = 0; u < 16; ++u) {
        const float a0 = __expf(__uint_as_float(lv[u] << 16)), a1 = __expf(__uint_as_float(lv[u] & 0xffff0000u));
        P0 *= a0; P1 *= a1;
        H0 = a0 * H0 + __uint_as_float(bv[u] << 16); H1 = a1 * H1 + __uint_as_float(bv[u] & 0xffff0000u);
      }
    }
    const size_t oi = (size_t)r * 1024 + ch;
    *(float2*)(cp + oi) = float2{P0, P1};
    *(float2*)(chh + oi) = float2{H0, H1};
  }
}
DI void lru_scan2(const float* cp, const float* chh, float* ci, char* smem) {
  float* gp = (float*)smem;
  float* gh = gp + 12 * 32;
  const int tid = opaque_tid();
  const int g = tid >> 5, cl = tid & 31;
  for (int task = opaque_bid(); task < 4 * 32; task += gridDim.x) {
    const int bd = task >> 5, ch = (task & 31) * 32 + cl;
    float pv[11], hv[11];
    if (g < 12) {
#pragma unroll
      for (int u = 0; u < 11; ++u) { const size_t idx = ((size_t)bd * NCH + g * 11 + u) * 1024 + ch; pv[u] = cp[idx]; hv[u] = chh[idx]; }
      float P = 1.f, H = 0.f;
#pragma unroll
      for (int u = 0; u < 11; ++u) { H = pv[u] * H + hv[u]; P *= pv[u]; }
      gp[g * 32 + cl] = P; gh[g * 32 + cl] = H;
    }
    __syncthreads();
    if (g < 12) {
      float carry = 0.f;
      for (int q = 0; q < g; ++q) carry = gp[q * 32 + cl] * carry + gh[q * 32 + cl];
#pragma unroll
      for (int u = 0; u < 11; ++u) {
        ci[((size_t)bd * NCH + g * 11 + u) * 1024 + ch] = carry;
        carry = pv[u] * carry + hv[u];
      }
    }
    __syncthreads();
  }
}
DI void lru_scan3(const bfu* la, const bfu* bb, const float* ci, const bfu* sg, bfu* y) {
  const int total = 2 * NCH * 512;
  for (int e = opaque_bid() * NTHR + opaque_tid(); e < total; e += gridDim.x * NTHR) {
    const int ch = (e & 511) * 2, r = e >> 9;
    const int tc = r % NCH, b = r / NCH;
    const int jb = tc < 4 ? 3 - tc : 135 - tc;
    const int mbase = b * TPB + tc * 64;
    float2 cv = *(const float2*)(ci + ((size_t)(b * 2 + 1) * NCH + jb) * 1024 + ch);
    float c0 = cv.x, c1 = cv.y;
    {
      const bfu* lp = la + ((size_t)(mbase + 63) * 2 + 1) * 1024 + ch;
      const bfu* bp = bb + ((size_t)(mbase + 63) * 2 + 1) * 1024 + ch;
      bfu* yp = y + (size_t)(mbase + 63) * 1024 + ch;
      for (int t8 = 0; t8 < 64; t8 += 16) {
        uint32_t lv[16], bv[16];
#pragma unroll
        for (int u = 0; u < 16; ++u) { lv[u] = *(const uint32_t*)(lp - (t8 + u) * 2048); bv[u] = *(const uint32_t*)(bp - (t8 + u) * 2048); }
#pragma unroll
        for (int u = 0; u < 16; ++u) {
          c0 = __expf(__uint_as_float(lv[u] << 16)) * c0 + __uint_as_float(bv[u] << 16);
          c1 = __expf(__uint_as_float(lv[u] & 0xffff0000u)) * c1 + __uint_as_float(bv[u] & 0xffff0000u);
          *(uint32_t*)(yp - (t8 + u) * 1024) = pack2(c0, c1);
        }
      }
    }
    cv = *(const float2*)(ci + ((size_t)(b * 2 + 0) * NCH + tc) * 1024 + ch);
    c0 = cv.x; c1 = cv.y;
    {
      const bfu* lp = la + ((size_t)mbase * 2 + 0) * 1024 + ch;
      const bfu* bp = bb + ((size_t)mbase * 2 + 0) * 1024 + ch;
      bfu* yp = y + (size_t)mbase * 1024 + ch;
      const bfu* sp = sg + (size_t)mbase * 1024 + ch;
      for (int t8 = 0; t8 < 64; t8 += 16) {
        uint32_t lv[16], bv[16], yv[16], sv[16];
#pragma unroll
        for (int u = 0; u < 16; ++u) {
          lv[u] = *(const uint32_t*)(lp + (t8 + u) * 2048); bv[u] = *(const uint32_t*)(bp + (t8 + u) * 2048);
          yv[u] = *(const uint32_t*)(yp + (t8 + u) * 1024); sv[u] = *(const uint32_t*)(sp + (t8 + u) * 1024);
        }
#pragma unroll
        for (int u = 0; u < 16; ++u) {
          c0 = __expf(__uint_as_float(lv[u] << 16)) * c0 + __uint_as_float(bv[u] << 16);
          c1 = __expf(__uint_as_float(lv[u] & 0xffff0000u)) * c1 + __uint_as_float(bv[u] & 0xffff0000u);
          const float o0 = (c0 + __uint_as_float(yv[u] << 16)) * __uint_as_float(sv[u] << 16);
          const float o1 = (c1 + __uint_as_float(yv[u] & 0xffff0000u)) * __uint_as_float(sv[u] & 0xffff0000u);
          *(uint32_t*)(yp + (t8 + u) * 1024) = pack2(o0, o1);
        }
      }
    }
  }
}

struct BaseIdent { DI long operator()(int r) const { return r; } };
struct BaseGdnIn { DI long operator()(int r) const { return r < 4096 ? (long)r : (r < 4160 ? (long)(6144 + r - 4096) : -1L); } };
struct BaseGdnZ { DI long operator()(int r) const { return 4096 + r; } };
struct BaseLruGate {
  int kind;
  DI long operator()(int r) const {
    const int k = (r >> 5) & 1;
    if (k != kind) return -1L;
    const int cc = r & 31, grp = r >> 6;
    const int cg8 = grp & 7, d = (grp >> 3) & 1, nb = grp >> 4;
    return (long)(d * 4 + nb) * 65536 + cg8 * 32 + cc;
  }
};

DI void lru_gate_transpose(const float* wr, const float* wi, bfu* dst, char* smem, int t_start = -1, int t_stride = 0) {
  float* tile = (float*)smem;
  const int tid = opaque_tid();
  if (t_start < 0) { t_start = opaque_bid(); t_stride = gridDim.x; }
  for (int t = t_start; t < 64 * 4; t += t_stride) {
    const int r0 = (t >> 2) * 64, k0 = (t & 3) * 64;
    {
      const int rr = tid & 63;
      const long b_r = BaseLruGate{0}(r0 + rr), b_i = BaseLruGate{1}(r0 + rr);
      const float* src = b_r >= 0 ? wr + b_r : wi + b_i;
#pragma unroll
      for (int i = 0; i < 8; ++i) {
        const int kk = i * 8 + (tid >> 6);
        tile[kk * 65 + rr] = src[(long)(k0 + kk) * 256];
      }
    }
    __syncthreads();
#pragma unroll
    for (int i = 0; i < 8; ++i) {
      const int e = i * 512 + tid;
      const int rr = e >> 6, kk = e & 63;
      dst[(size_t)(r0 + rr) * 256 + k0 + kk] = f2bf(tile[kk * 65 + rr]);
    }
    __syncthreads();
  }
}


struct FillLruWeights {
  const float* w_in; const float* w_r; const float* w_i; const float* w_out; bfu* wt_in; bfu* wt_gate; bfu* wt_out; char* smem;
  DI void operator()(int start, int stride) const {
    transpose_phase(w_in, 2048, 1024, 2048, wt_in, BaseIdent(), smem, start, stride);
    lru_gate_transpose(w_r, w_i, wt_gate, smem, start, stride);
    transpose_phase(w_out, 1024, 1024, 1024, wt_out, BaseIdent(), smem, start, stride);
  }
};
struct FillGdnIn {
  const float* w_in; bfu* wt; char* smem;
  DI void operator()(int start, int stride) const { transpose_phase(w_in, 6208, 1024, 4224, wt, BaseGdnIn(), smem, start, stride); }
};

__global__ void __launch_bounds__(NTHR) fwd_megakernel(Params p) {
  cg::grid_group grid = cg::this_grid();
  __shared__ __attribute__((aligned(16))) char smem[151552];
  __shared__ uint4 xb_words;
  if (threadIdx.x == 0) xb_words = make_uint4(0u, 0u, 0u, 0u);
  __syncthreads();
  const XcdBarrier gbar = xcd_barrier_post((unsigned*)(p.ws + OFF_BAR), (volatile LAS unsigned*)&xb_words);
  char* ws = p.ws;
  float* mod = (float*)(ws + OFF_MOD);
  float* ctxres = (float*)(ws + OFF_CTXRES);
  bfu* wt = (bfu*)(ws + OFF_WT);
  bfu* h = (bfu*)(ws + OFF_H);

  mod_phase(p, mod, smem);
  transpose_phase(p.gdn_w_in, 6208, 1024, 4224, wt, BaseGdnIn(), smem);
  for (int i = opaque_bid() * NTHR + opaque_tid(); i < 512 * 1024 / 4; i += gridDim.x * NTHR)
    ((float4*)ctxres)[i] = ((const float4*)p.ctx)[i];
  grid.sync();

  unsigned lb_count = 0;
  for (int layer = 0; layer < 4; ++layer) {
    const int j = layer >> 1;
    const bool colmajor = ((layer + layer / 2) & 1) == 1;
    const float* xsrc = layer == 0 ? p.x : p.out;
    const float* modl = mod + (size_t)layer * 3 * 3072;
    if ((layer & 1) == 0) {
      bfu* proj = (bfu*)(ws + OFF_PROJ);
      bfu* halo = (bfu*)(ws + OFF_HALO);
      bfu* o = (bfu*)(ws + OFF_O);
      bfu* octx2 = (bfu*)(ws + OFF_OCTX2);
      float* gab = (float*)(ws + OFF_GG);
      const float* w_in = p.gdn_w_in + (size_t)j * 1024 * 6208;
      norm_phase(xsrc, ctxres, p.norm_g + layer * 1024, modl, colmajor, h);
      xcd_barrier(gbar);
      gemm_phase(h, 1024, wt, 1024, 1024, 68, 33, KOffZero(),
                 EpiGdn1Conv{proj, gab, p.gdn_conv + (size_t)j * 4 * 4096}, smem, true);
      xcd_barrier(gbar);
      gdn_chunked(proj, gab, p.gdn_a_log + j * 32, p.gdn_dt_bias + j * 32, h, (float*)halo, o, octx2, smem, gbar, lb_count);
      norm_phase(xsrc, ctxres, p.norm_g + layer * 1024, modl, colmajor, h);
      transpose_phase(w_in, 6208, 1024, 2048, wt, BaseGdnZ(), smem);
      transpose_phase(p.gdn_w_out + (size_t)j * 2048 * 1024, 1024, 2048, 1024, wt + 2048 * 1024, BaseIdent(), smem);
      xcd_barrier(gbar);
      gemm_phase(h, 1024, wt, 1024, 1024, 66, 16, KOffZero(), EpiZGate{o, octx2, p.gdn_norm_g + j * 128}, smem);
      xcd_barrier(gbar);
      gemm_phase(o, 2048, wt + 2048 * 1024, 2048, 2048, 66, 8, KOffZero(),
                 EpiResid{xsrc, p.out, ctxres, modl, colmajor, layer < 3}, smem, false,
                 FillLruWeights{p.lru_w_in + (size_t)j * 1024 * 2048, p.lru_w_r + (size_t)j * 2 * 4 * 65536, p.lru_w_i + (size_t)j * 2 * 4 * 65536,
                                p.lru_w_out + (size_t)j * 1024 * 1024, (bfu*)(ws + OFF_HALO), (bfu*)(ws + OFF_GG), (bfu*)(ws + OFF_GG) + 4096 * 256, smem});
      xcd_barrier(gbar);
    } else {
      bfu* xb = (bfu*)(ws + OFF_XB);
      bfu* sg = (bfu*)(ws + OFF_SG);
      bfu* la = (bfu*)(ws + OFF_LA);
      bfu* bb = (bfu*)(ws + OFF_BB);
      float* cp = (float*)(ws + OFF_CP);
      float* chh = (float*)(ws + OFF_CH);
      float* ci = (float*)(ws + OFF_CI);
      bfu* xc = xb;
      bfu* yin = h;
      bfu* wt_in = (bfu*)(ws + OFF_HALO);
      bfu* wt_gate = (bfu*)(ws + OFF_GG);
      bfu* wt_out = wt_gate + 4096 * 256;
      norm_phase(xsrc, ctxres, p.norm_g + layer * 1024, modl, colmajor, h);
      float* spl = (float*)(ws + OFF_SPL);
      for (int i = opaque_bid() * NTHR + opaque_tid(); i < 2048; i += gridDim.x * NTHR) spl[i] = softplus_f(-p.lru_lambda[j * 2048 + i]);
      xcd_barrier(gbar);
      gemm_phase(h, 1024, wt_in, 1024, 1024, 68, 16, KOffZero(),
                 EpiLruInConv{xc, sg, p.lru_conv_w + (size_t)j * 4 * 1024, p.lru_conv_b + j * 1024}, smem, true);
      xcd_barrier(gbar);
      gemm_phase(xc, 1024, wt_gate, 256, 256, 66, 32, KOffLruGate(),
                 EpiLruGate{xc, la, bb, p.lru_b_r + j * 2048, p.lru_b_i + j * 2048, spl}, smem);
      xcd_barrier(gbar);
      lru_scan1(la, bb, cp, chh);
      xcd_barrier(gbar);
      lru_scan2(cp, chh, ci, smem);
      xcd_barrier(gbar);
      lru_scan3(la, bb, ci, sg, yin);
      xcd_barrier(gbar);
      if (layer == 1)
        gemm_phase(yin, 1024, wt_out, 1024, 1024, 66, 8, KOffZero(),
                   EpiResid{xsrc, p.out, ctxres, modl, colmajor, layer < 3}, smem, false,
                   FillGdnIn{p.gdn_w_in + (size_t)1 * 1024 * 6208, wt, smem});
      else
        gemm_phase(yin, 1024, wt_out, 1024, 1024, 66, 8, KOffZero(),
                   EpiResid{xsrc, p.out, ctxres, modl, colmajor, layer < 3}, smem);
      xcd_barrier(gbar);
    }
  }
  final_norm_phase(p.out, p.final_g);
}

extern "C" void kernel_launch(void* const* d_in, const int* in_sizes, int n_in, void* d_out, int out_size, void* d_ws,
                              size_t ws_size, hipStream_t stream) {
  static int grid_blocks = 0;
  if (!grid_blocks) {
    int dev = 0, cus = 0, per_cu = 0;
    (void)hipGetDevice(&dev);
    (void)hipDeviceGetAttribute(&cus, hipDeviceAttributeMultiprocessorCount, dev);
    (void)hipOccupancyMaxActiveBlocksPerMultiprocessor(&per_cu, fwd_megakernel, NTHR, 0);
    if (per_cu > 1) per_cu = 1;
    grid_blocks = cus * per_cu;
  }
  Params p{};
  p.x = (const float*)d_in[0]; p.c = (const float*)d_in[1]; p.ctx = (const float*)d_in[2]; p.c_ctx = (const float*)d_in[3];
  p.mod_w = (const float*)d_in[4]; p.mod_b = (const float*)d_in[5]; p.norm_g = (const float*)d_in[6];
  p.gdn_w_in = (const float*)d_in[7]; p.gdn_conv = (const float*)d_in[8]; p.gdn_a_log = (const float*)d_in[9];
  p.gdn_dt_bias = (const float*)d_in[10]; p.gdn_norm_g = (const float*)d_in[11]; p.gdn_w_out = (const float*)d_in[12];
  p.lru_w_in = (const float*)d_in[13]; p.lru_conv_w = (const float*)d_in[14]; p.lru_conv_b = (const float*)d_in[15];
  p.lru_w_r = (const float*)d_in[16]; p.lru_b_r = (const float*)d_in[17]; p.lru_w_i = (const float*)d_in[18];
  p.lru_b_i = (const float*)d_in[19]; p.lru_lambda = (const float*)d_in[20]; p.lru_w_out = (const float*)d_in[21];
  p.final_g = (const float*)d_in[22];
  p.out = (float*)d_out;
  p.ws = (char*)d_ws;
  (void)hipMemsetAsync((char*)d_ws + OFF_BAR, 0, 16384, stream);
  void* args[] = {&p};
  hipError_t e = hipLaunchCooperativeKernel((void*)fwd_megakernel, dim3(grid_blocks), dim3(NTHR), args, 0, stream);
  if (e != hipSuccess) fprintf(stderr, "cooperative launch failed: %s (grid %d)\n", hipGetErrorString(e), grid_blocks);
}
```

```cpp
#include <hip/hip_runtime.h>
#include <hip/hip_cooperative_groups.h>
#include <stdint.h>
#include <cstdio>
namespace cg = cooperative_groups;

typedef unsigned short bfu;
using bf16x8 = __attribute__((ext_vector_type(8))) short;
using f32x4 = __attribute__((ext_vector_type(4))) float;

#define DI __device__ __forceinline__
constexpr int NTHR = 512;
constexpr int D = 1024, SEQ = 8192, CTX = 256, TPB = 8448, M = 16896;
constexpr int NCH = 132;

DI int opaque_tid() { int t = threadIdx.x; asm volatile("" : "+v"(t)); return t; }
DI int opaque_bid() { int b = blockIdx.x; asm volatile("" : "+s"(b)); return b; }

#define XB_TMO      128
#define XB_XCNT(j)  (256  + 64 * (j))
#define XB_XSUB(j)  (1280 + 64 * (j))
#define XB_XGEN(j)  (2304 + 64 * (j))
#define XB_TOP      3328
#define XB_TOPGEN   3392
#define XCD_BAR_WORDS 3456
#define XB_SPIN_CAP (1u << 18)
#define LAS __attribute__((address_space(3)))

__device__ __forceinline__ unsigned xb_ld(unsigned* p)              { return __hip_atomic_load(p, __ATOMIC_RELAXED, __HIP_MEMORY_SCOPE_AGENT); }
__device__ __forceinline__ unsigned xb_add(unsigned* p, unsigned v) { return __hip_atomic_fetch_add(p, v, __ATOMIC_RELAXED, __HIP_MEMORY_SCOPE_AGENT); }
__device__ __forceinline__ unsigned xb_xcc_id() { return (unsigned)__builtin_amdgcn_s_getreg((3 << 11) | 20) & 0xFu; }
#define XB_SPIN(cond, bar) do { unsigned _sp = 0; while (cond) { __builtin_amdgcn_s_sleep(1); \
    if ((++_sp & 255u) == 0u) { if (xb_ld(&(bar)[XB_TMO])) break; if (_sp > XB_SPIN_CAP) { atomicAdd(&(bar)[XB_TMO], 1u); break; } } } } while (0)

struct XcdBarrier {
    unsigned* bar; unsigned x;
    volatile LAS unsigned* st;
};

__device__ __forceinline__ XcdBarrier xcd_barrier_post(unsigned* bar, volatile LAS unsigned* st) {
    XcdBarrier b; b.bar = bar; b.x = xb_xcc_id(); b.st = st;
    if (threadIdx.x == 0) (void)xb_add(&bar[XB_XCNT(b.x)], 1u);
    return b;
}
__device__ __forceinline__ void xcd_barrier_complete(unsigned* bar, unsigned x, unsigned& nloc, unsigned& nx) {
    const unsigned G = gridDim.x * gridDim.y * gridDim.z;
    unsigned sum, cnt, mine, sp = 0u;
    for (;;) {
        sum = 0u; cnt = 0u; mine = 0u;
#pragma unroll
        for (unsigned j = 0; j < 16; ++j) { const unsigned c = xb_ld(&bar[XB_XCNT(j)]); sum += c; cnt += (c > 0u) ? 1u : 0u; mine = (j == x) ? c : mine; }
        if (sum == G) break;
        __builtin_amdgcn_s_sleep(1);
        if ((++sp & 255u) == 0u) { if (xb_ld(&bar[XB_TMO])) break; if (sp > XB_SPIN_CAP) { atomicAdd(&bar[XB_TMO], 1u); break; } }
    }
    nloc = mine > 0u ? mine : 1u; nx = cnt > 0u ? cnt : 1u;
}

__device__ __forceinline__ void xcd_barrier(const XcdBarrier& b) {
    asm volatile("s_waitcnt vmcnt(0)" ::: "memory");
    __syncthreads();
    if (threadIdx.x == 0) {
        unsigned* bar = b.bar;
        __builtin_amdgcn_s_waitcnt(0);
        unsigned nloc = b.st[0], nx = b.st[1];
        if (nloc == 0u) { xcd_barrier_complete(bar, b.x, nloc, nx); b.st[0] = nloc; b.st[1] = nx; }
        const unsigned old = xb_add(&bar[XB_XSUB(b.x)], 1u);
        const unsigned gen = old / nloc;
        if (old + 1u == (gen + 1u) * nloc) {
            __builtin_amdgcn_fence(__ATOMIC_RELEASE, "agent");
            asm volatile("s_waitcnt vmcnt(0)" ::: "memory");
            const unsigned og = xb_add(&bar[XB_TOP], 1u);
            const unsigned tg = og / nx;
            if (og + 1u == (tg + 1u) * nx) xb_add(&bar[XB_TOPGEN], 1u);
            else XB_SPIN(xb_ld(&bar[XB_TOPGEN]) == tg, bar);
            __builtin_amdgcn_fence(__ATOMIC_ACQUIRE, "agent");
            xb_add(&bar[XB_XGEN(b.x)], 1u);
            asm volatile("s_waitcnt vmcnt(0)" ::: "memory");
        } else {
            XB_SPIN(xb_ld(&bar[XB_XGEN(b.x)]) == gen, bar);
            __builtin_amdgcn_fence(__ATOMIC_ACQUIRE, "agent");
            asm volatile("s_waitcnt vmcnt(0)" ::: "memory");
        }
    }
    __syncthreads();
}


__device__ __forceinline__ void xcd_barrier_exec(const XcdBarrier& b) {
    asm volatile("s_waitcnt vmcnt(0)" ::: "memory");
    __syncthreads();
    if (threadIdx.x == 0) {
        unsigned* bar = b.bar;
        __builtin_amdgcn_s_waitcnt(0);
        unsigned nloc = b.st[0], nx = b.st[1];
        if (nloc == 0u) { xcd_barrier_complete(bar, b.x, nloc, nx); b.st[0] = nloc; b.st[1] = nx; }
        const unsigned old = xb_add(&bar[XB_XSUB(b.x)], 1u);
        const unsigned gen = old / nloc;
        if (old + 1u == (gen + 1u) * nloc) {
            asm volatile("s_waitcnt vmcnt(0)" ::: "memory");
            const unsigned og = xb_add(&bar[XB_TOP], 1u);
            const unsigned tg = og / nx;
            if (og + 1u == (tg + 1u) * nx) xb_add(&bar[XB_TOPGEN], 1u);
            else XB_SPIN(xb_ld(&bar[XB_TOPGEN]) == tg, bar);
            xb_add(&bar[XB_XGEN(b.x)], 1u);
            asm volatile("s_waitcnt vmcnt(0)" ::: "memory");
        } else {
            XB_SPIN(xb_ld(&bar[XB_XGEN(b.x)]) == gen, bar);
            asm volatile("s_waitcnt vmcnt(0)" ::: "memory");
        }
    }
    __syncthreads();
}


constexpr size_t OFF_BAR = 268435456 - 16384;
DI void light_barrier(unsigned* cnt, unsigned target) {
  asm volatile("s_waitcnt vmcnt(0)" ::: "memory");
  __syncthreads();
  if (threadIdx.x == 0) {
    xb_add(cnt, 1u);
    unsigned sp = 0;
    while (xb_ld(cnt) < target) { __builtin_amdgcn_s_sleep(1); if (++sp > (1u << 22)) break; }
  }
  __syncthreads();
}
typedef __attribute__((ext_vector_type(2))) float f32x2_t;
typedef __attribute__((ext_vector_type(2))) __bf16 bf16x2_t;
DI uint32_t pack2(float a, float b) { f32x2_t v = {a, b}; return __builtin_bit_cast(uint32_t, __builtin_convertvector(v, bf16x2_t)); }
DI bfu f2bf(float x) { return (bfu)(pack2(x, x) & 0xffffu); }
DI float bf2f(bfu x) { return __uint_as_float(((uint32_t)x) << 16); }
DI float sigmoid_f(float x) { return __builtin_amdgcn_rcpf(1.f + __expf(-x)); }
DI float silu_f(float x) { return x * sigmoid_f(x); }
DI float one_minus_exp(float y) { return y > -0.03f ? -y * (1.f + y * (0.5f + y * 0.16666667f)) : 1.f - __expf(y); }
DI float softplus_f(float x) { return x > 20.f ? x : log1pf(__expf(x)); }
DI float wave_sum(float v) {
#pragma unroll
  for (int o = 32; o >= 1; o >>= 1) v += __shfl_xor(v, o);
  return v;
}

struct Params {
  const float *x, *c, *ctx, *c_ctx, *mod_w, *mod_b, *norm_g, *gdn_w_in, *gdn_conv, *gdn_a_log, *gdn_dt_bias, *gdn_norm_g,
      *gdn_w_out, *lru_w_in, *lru_conv_w, *lru_conv_b, *lru_w_r, *lru_b_r, *lru_w_i, *lru_b_i, *lru_lambda, *lru_w_out, *final_g;
  float* out;
  char* ws;
};

constexpr size_t OFF_MOD = 0;
constexpr size_t OFF_CTXRES = OFF_MOD + 147456;
constexpr size_t OFF_WT = OFF_CTXRES + 2097152;
constexpr size_t OFF_H = OFF_WT + 8650752;
constexpr size_t OFF_L = OFF_H + 34603008;
constexpr size_t OFF_PROJ = OFF_L;
constexpr size_t OFF_HALO = OFF_PROJ + 138412032;
constexpr size_t OFF_O = OFF_HALO + 6488064;
constexpr size_t OFF_OCTX2 = OFF_O + 69206016;
constexpr size_t OFF_GG = OFF_OCTX2 + 2097152;
constexpr size_t OFF_GB = OFF_GG + 2162688;
constexpr size_t END_GDN = OFF_GB + 2162688;
constexpr size_t OFF_XB = OFF_L;
constexpr size_t OFF_SG = OFF_XB + 34603008;
constexpr size_t OFF_LA = OFF_SG + 34603008;
constexpr size_t OFF_BB = OFF_LA + 69206016;
constexpr size_t OFF_CP = OFF_BB + 69206016;
constexpr size_t OFF_CH = OFF_CP + 2162688;
constexpr size_t OFF_CI = OFF_CH + 2162688;
constexpr size_t OFF_SPL = OFF_CI + 2162688;
constexpr size_t END_LRU = OFF_SPL + 8192;
static_assert(END_GDN <= 268435456, "ws overflow gdn");
static_assert(END_LRU <= 268435456, "ws overflow lru");

DI int res_row(int m, bool colmajor) {
  int b = m / TPB, p = m - b * TPB;
  if (p < CTX) return -(b * CTX + p) - 1;
  int s = p - CTX;
  int t = colmajor ? ((s & 127) * 64 + (s >> 7)) : s;
  return b * SEQ + t;
}
DI int chain_row(int b, int dir, int pos) {
  int p = dir == 0 ? pos : (pos < CTX ? (CTX - 1 - pos) : (TPB + CTX - 1 - pos));
  return b * TPB + p;
}

template <class BaseF>
DI void transpose_phase(const float* __restrict__ src, int ld, int K, int nrows, bfu* __restrict__ dst, BaseF basef, char* smem) {
  float* tile = (float*)smem;
  const int tid = opaque_tid();
  const int rt = nrows / 64, kt = K / 64;
  for (int t = opaque_bid(); t < rt * kt; t += gridDim.x) {
    const int r0 = (t / kt) * 64, k0 = (t % kt) * 64;
    {
      const int rr = tid & 63;
      const long base = basef(r0 + rr);
#pragma unroll
      for (int i = 0; i < 8; ++i) {
        const int kk = i * 8 + (tid >> 6);
        tile[kk * 65 + rr] = base < 0 ? 0.f : src[base + (long)(k0 + kk) * ld];
      }
    }
    __syncthreads();
#pragma unroll
    for (int i = 0; i < 8; ++i) {
      const int e = i * 512 + tid;
      const int rr = e >> 6, kk = e & 63;
      dst[(size_t)(r0 + rr) * K + k0 + kk] = f2bf(tile[kk * 65 + rr]);
    }
    __syncthreads();
  }
}

template <class Epi, class KOff>
DI void gemm_phase(const bfu* __restrict__ A, int lda, const bfu* __restrict__ Bt, int ldb, int K, int Mt, int Nt, KOff koff,
                   Epi epi, char* smem, bool gdnmap = false) {
  bfu* As = (bfu*)smem;
  bfu* Bs = As + 2 * 256 * 72;
  const int ntiles = Mt * Nt;
  const int nk = K / 64;
  int tile = opaque_bid();
  if (tile >= ntiles) return;
  const int tid = opaque_tid(), lane = tid & 63, wid = tid >> 6;
  const int wm = wid >> 1, wn = wid & 1;
  const int r16 = lane & 15, quad = lane >> 4;
  const int arow = tid >> 3, akq = tid & 7;
  uint4 p0, p1, p2, p3, p4, p5, q0, q1, q2, q3, q4, q5;
#define G_LOAD(x0, x1, x2, x3, x4, x5, kt_) do { const bfu* ap_ = ag + (kt_) * 64; const bfu* bp_ = bg + (kt_) * 64; \
      x0 = *(const uint4*)(ap_); x1 = *(const uint4*)(ap_ + (size_t)64 * lda); x2 = *(const uint4*)(ap_ + (size_t)128 * lda); x3 = *(const uint4*)(ap_ + (size_t)192 * lda); \
      x4 = *(const uint4*)(bp_); x5 = *(const uint4*)(bp_ + (size_t)64 * ldb); } while (0)
#define G_STORE(x0, x1, x2, x3, x4, x5, buf_) do { bfu* as_ = As + ((buf_) * 256 + arow) * 72 + akq * 8; bfu* bs_ = Bs + ((buf_) * 128 + arow) * 72 + akq * 8; \
      *(uint4*)(as_) = x0; *(uint4*)(as_ + 64 * 72) = x1; *(uint4*)(as_ + 128 * 72) = x2; *(uint4*)(as_ + 192 * 72) = x3; \
      *(uint4*)(bs_) = x4; *(uint4*)(bs_ + 64 * 72) = x5; } while (0)
#define R0 p0, p1, p2, p3, p4, p5
#define R1 q0, q1, q2, q3, q4, q5
#define G_LOADR(R, kt_) G_LOAD(R, kt_)
#define G_STORER(R, buf_) G_STORE(R, buf_)
#define G_COMPUTE(buf_) do { _Pragma("unroll") for (int ks_ = 0; ks_ < 2; ++ks_) { bf16x8 af[4], bfr[4]; \
      _Pragma("unroll") for (int i = 0; i < 4; ++i) af[i] = *(const bf16x8*)(As + ((buf_) * 256 + wm * 64 + i * 16 + r16) * 72 + ks_ * 32 + quad * 8); \
      _Pragma("unroll") for (int j = 0; j < 4; ++j) bfr[j] = *(const bf16x8*)(Bs + ((buf_) * 128 + wn * 64 + j * 16 + r16) * 72 + ks_ * 32 + quad * 8); \
      _Pragma("unroll") for (int i = 0; i < 4; ++i) _Pragma("unroll") for (int j = 0; j < 4; ++j) \
        acc[i][j] = __builtin_amdgcn_mfma_f32_16x16x32_bf16(af[i], bfr[j], acc[i][j], 0, 0, 0); } } while (0)
  int mt = tile / Nt, nt = tile - mt * Nt;
#define M_BASE(mt_) (gdnmap ? (((mt_) / 34) * TPB + (((mt_) % 34) == 0 ? 0 : 254 + 253 * (((mt_) % 34) - 1))) : (mt_) * 256)
  const bfu* ag = A + (size_t)(M_BASE(mt) + arow) * lda + koff(nt) + akq * 8;
  const bfu* bg = Bt + (size_t)(nt * 128 + arow) * ldb + akq * 8;
  G_LOADR(R0, 0);
  G_LOADR(R1, 1);
  if (__builtin_amdgcn_readfirstlane(tid) >= 256) __builtin_amdgcn_s_setprio(1);
  for (;;) {
    const int cm0 = M_BASE(mt), cn0 = nt * 128, cnt = nt;
    f32x4 acc[4][4];
#pragma unroll
    for (int i = 0; i < 4; ++i)
#pragma unroll
      for (int j = 0; j < 4; ++j) acc[i][j] = f32x4{0.f, 0.f, 0.f, 0.f};
    G_STORER(R0, 0);
    p0 = q0; p1 = q1; p2 = q2; p3 = q3; p4 = q4; p5 = q5;
    G_LOADR(R1, 2);
    __syncthreads();
    for (int kt = 0; kt < nk; kt += 2) {
      G_STORER(R0, 1);
      if (kt + 3 < nk) G_LOADR(R0, kt + 3);
      G_COMPUTE(0);
      __syncthreads();
      if (kt + 2 < nk) G_STORER(R1, 0);
      if (kt + 4 < nk) G_LOADR(R1, kt + 4);
      G_COMPUTE(1);
      __syncthreads();
    }
    tile += gridDim.x;
    const bool more = tile < ntiles;
    if (more) {
      mt = tile / Nt; nt = tile - mt * Nt;
      ag = A + (size_t)(M_BASE(mt) + arow) * lda + koff(nt) + akq * 8;
      bg = Bt + (size_t)(nt * 128 + arow) * ldb + akq * 8;
      G_LOADR(R0, 0);
      G_LOADR(R1, 1);
    }
    float* Cs = (float*)smem;
#pragma unroll
    for (int i = 0; i < 4; ++i)
#pragma unroll
      for (int j = 0; j < 4; ++j)
#pragma unroll
        for (int e = 0; e < 4; ++e) Cs[(wm * 64 + i * 16 + quad * 4 + e) * 132 + wn * 64 + j * 16 + r16] = acc[i][j][e];
    __syncthreads();
    epi(cm0, cn0, cnt, Cs, tid);
    __syncthreads();
    if (!more) break;
  }
  __builtin_amdgcn_s_setprio(0);
#undef G_LOAD
#undef G_STORE
#undef G_LOADR
#undef G_STORER
#undef R0
#undef R1
#undef G_COMPUTE
#undef M_BASE
}

struct KOffZero { DI int operator()(int) const { return 0; } };
struct KOffLruGate { DI int operator()(int nt) const { return (nt >> 3) * 256; } };

DI void ld8(const float* Cs, int row, int col8, float (&v)[8]) {
  const float4 a = *(const float4*)(Cs + row * 132 + col8), b = *(const float4*)(Cs + row * 132 + col8 + 4);
  v[0] = a.x; v[1] = a.y; v[2] = a.z; v[3] = a.w; v[4] = b.x; v[5] = b.y; v[6] = b.z; v[7] = b.w;
}
DI uint4 pack8(const float (&v)[8]) { uint4 o = {pack2(v[0], v[1]), pack2(v[2], v[3]), pack2(v[4], v[5]), pack2(v[6], v[7])}; return o; }
DI void unpack8(const uint4 u, float (&v)[8]) {
  v[0] = __uint_as_float(u.x << 16); v[1] = __uint_as_float(u.x & 0xffff0000u); v[2] = __uint_as_float(u.y << 16); v[3] = __uint_as_float(u.y & 0xffff0000u);
  v[4] = __uint_as_float(u.z << 16); v[5] = __uint_as_float(u.z & 0xffff0000u); v[6] = __uint_as_float(u.w << 16); v[7] = __uint_as_float(u.w & 0xffff0000u);
}

struct EpiGdn1 {
  bfu* proj; bfu* halo; float* ab;
  DI void operator()(int m0, int n0, int nt, const float* Cs, int tid) const {
    if (nt < 32) {
#pragma unroll
      for (int k = 0; k < 8; ++k) {
        const int c = tid + 512 * k, row = c >> 4, col8 = (c & 15) * 8;
        float v[8]; ld8(Cs, row, col8, v);
        const uint4 pv = pack8(v);
        const int m = m0 + row, n = n0 + col8;
        *(uint4*)(proj + (size_t)m * 4096 + n) = pv;
        const int r = m & 63, T = m >> 6;
        if (r >= 62 && T + 1 < 264) *(uint4*)(halo + ((size_t)(T + 1) * 3 + (r - 62)) * 4096 + n) = pv;
        if (r == 0 && T >= 1) *(uint4*)(halo + ((size_t)(T - 1) * 3 + 2) * 4096 + n) = pv;
      }
    } else {
#pragma unroll
      for (int k = 0; k < 4; ++k) {
        const int c = tid + 512 * k, row = c >> 3, col8 = (c & 7) * 8;
        float v[8]; ld8(Cs, row, col8, v);
        float* dst = ab + (size_t)(m0 + row) * 64 + col8;
        *(float4*)dst = float4{v[0], v[1], v[2], v[3]};
        *(float4*)(dst + 4) = float4{v[4], v[5], v[6], v[7]};
      }
    }
  }
};

struct EpiGdn1Conv {
  bfu* proj; float* ab; const float* cw;
  DI void operator()(int m0, int n0, int nt, const float* Cs, int tid) const {
    const int b = m0 / TPB, p0 = m0 - b * TPB;
    int vlo, vhi, olo, ohi;
    if (p0 == 0) { vlo = 0; vhi = 256; olo = 0; ohi = 256; }
    else { const int s0 = p0 - CTX; vlo = s0 < 0 ? -s0 : 0; vhi = SEQ - s0 < 256 ? SEQ - s0 : 256; olo = 2; ohi = vhi < 255 ? vhi : 255; }
    if (nt < 32) {
      const int col8 = (tid & 15) * 8, n = n0 + col8;
      float w[4][8];
#pragma unroll
      for (int j = 0; j < 4; ++j) {
        const float4 w0 = *(const float4*)(cw + j * 4096 + n), w1 = *(const float4*)(cw + j * 4096 + n + 4);
        w[j][0] = w0.x; w[j][1] = w0.y; w[j][2] = w0.z; w[j][3] = w0.w; w[j][4] = w1.x; w[j][5] = w1.y; w[j][6] = w1.z; w[j][7] = w1.w;
      }
#pragma unroll
      for (int k = 0; k < 8; ++k) {
        const int row = (tid >> 4) + 32 * k;
        float y[8];
#pragma unroll
        for (int e = 0; e < 8; ++e) y[e] = 0.f;
#pragma unroll
        for (int j = 0; j < 4; ++j) {
          const int rr = row - 2 + j;
          if (rr >= vlo && rr < vhi) {
            float x[8]; ld8(Cs, rr, col8, x);
#pragma unroll
            for (int e = 0; e < 8; ++e) y[e] += w[j][e] * x[e];
          }
        }
        float ss = 0.f;
#pragma unroll
        for (int e = 0; e < 8; ++e) { y[e] = silu_f(y[e]); ss += y[e] * y[e]; }
        if (n0 < 2048) {
#pragma unroll
          for (int off = 8; off >= 1; off >>= 1) ss += __shfl_xor(ss, off);
          float sc = rsqrtf(ss + 1e-6f);
          if (n0 < 1024) sc *= 0.08838834764831845f;
#pragma unroll
          for (int e = 0; e < 8; ++e) y[e] *= sc;
        }
        if (row >= olo && row < ohi) *(uint4*)(proj + (size_t)(m0 + row) * 4096 + n) = pack8(y);
      }
    } else {
#pragma unroll
      for (int k = 0; k < 4; ++k) {
        const int c = tid + 512 * k, row = c >> 3, col8 = (c & 7) * 8;
        if (row >= olo && row < ohi) {
          float v[8]; ld8(Cs, row, col8, v);
          float* dst = ab + (size_t)(m0 + row) * 64 + col8;
          *(float4*)dst = float4{v[0], v[1], v[2], v[3]};
          *(float4*)(dst + 4) = float4{v[4], v[5], v[6], v[7]};
        }
      }
    }
  }
};

struct EpiZGate {
  bfu* a2; const bfu* octx2; const float* ng;
  DI void operator()(int m0, int n0, int nt, const float* Cs, int tid) const {
#pragma unroll
    for (int k = 0; k < 8; ++k) {
      const int c = tid + 512 * k, row = c >> 4, col8 = (c & 15) * 8;
      float v[8], a[8]; ld8(Cs, row, col8, v);
      const int m = m0 + row;
      bfu* ptr = a2 + (size_t)m * 2048 + n0 + col8;
      unpack8(*(const uint4*)ptr, a);
      const int b = m / TPB, p = m - b * TPB;
      if (p < CTX) {
        float a2v[8];
        unpack8(*(const uint4*)(octx2 + (size_t)(b * CTX + p) * 2048 + n0 + col8), a2v);
#pragma unroll
        for (int e = 0; e < 8; ++e) a[e] += a2v[e];
      }
      float ss = 0.f;
#pragma unroll
      for (int e = 0; e < 8; ++e) ss += a[e] * a[e];
#pragma unroll
      for (int off = 8; off >= 1; off >>= 1) ss += __shfl_xor(ss, off);
      const float rstd = rsqrtf(ss * (1.0f / 128.0f) + 1e-6f);
      const float4 g0 = *(const float4*)(ng + col8), g1 = *(const float4*)(ng + col8 + 4);
      const float gv[8] = {g0.x, g0.y, g0.z, g0.w, g1.x, g1.y, g1.z, g1.w};
#pragma unroll
      for (int e = 0; e < 8; ++e) a[e] = bf2f(f2bf(a[e] * rstd * gv[e])) * silu_f(v[e]);
      *(uint4*)ptr = pack8(a);
    }
  }
};

struct EpiResid {
  const float* xsrc; float* xdst; float* ctxres; const float* modl;
  bool colmajor; bool upd_ctx;
  DI void operator()(int m0, int n0, int nt, const float* Cs, int tid) const {
#pragma unroll
    for (int k = 0; k < 8; ++k) {
      const int c = tid + 512 * k, row = c >> 4, col8 = (c & 15) * 8;
      float v[8]; ld8(Cs, row, col8, v);
      const int rr = res_row(m0 + row, colmajor);
      const int n = n0 + col8;
      const float* src; float* dst; int vsel;
      if (rr >= 0) { src = xsrc + (size_t)rr * 1024 + n; dst = xdst + (size_t)rr * 1024 + n; vsel = rr >> 13; }
      else { src = ctxres + (size_t)(-rr - 1) * 1024 + n; dst = ctxres + (size_t)(-rr - 1) * 1024 + n; vsel = 2; }
      if (rr >= 0 || upd_ctx) {
        const float* gp = modl + vsel * 3072 + 2048 + n;
        const float4 g0 = *(const float4*)gp, g1 = *(const float4*)(gp + 4);
        const float4 x0 = *(const float4*)src, x1 = *(const float4*)(src + 4);
        *(float4*)dst = float4{x0.x + g0.x * v[0], x0.y + g0.y * v[1], x0.z + g0.z * v[2], x0.w + g0.w * v[3]};
        *(float4*)(dst + 4) = float4{x1.x + g1.x * v[4], x1.y + g1.y * v[5], x1.z + g1.z * v[6], x1.w + g1.w * v[7]};
      }
    }
  }
};

struct EpiLruIn {
  bfu* xb; bfu* sg;
  DI void operator()(int m0, int n0, int nt, const float* Cs, int tid) const {
#pragma unroll
    for (int k = 0; k < 8; ++k) {
      const int c = tid + 512 * k, row = c >> 4, col8 = (c & 15) * 8;
      float v[8]; ld8(Cs, row, col8, v);
      const int n = n0 + col8;
      if (n < 1024) *(uint4*)(xb + (size_t)(m0 + row) * 1024 + n) = pack8(v);
      else {
#pragma unroll
        for (int e = 0; e < 8; ++e) v[e] = silu_f(v[e]);
        *(uint4*)(sg + (size_t)(m0 + row) * 1024 + n - 1024) = pack8(v);
      }
    }
  }
};

struct EpiLruInConv {
  bfu* xc; bfu* sg; const float* cw; const float* cb;
  DI void operator()(int m0, int n0, int nt, const float* Cs, int tid) const {
    const int b = m0 / TPB, p0 = m0 - b * TPB;
    int vlo, vhi, olo, ohi;
    if (p0 == 0) { vlo = 0; vhi = 256; olo = 0; ohi = 256; }
    else { const int s0 = p0 - CTX; vlo = s0 < 0 ? -s0 : 0; vhi = SEQ - s0 < 256 ? SEQ - s0 : 256; olo = 2; ohi = vhi < 255 ? vhi : 255; }
    const int col8 = (tid & 15) * 8, n = n0 + col8;
    if (n0 < 1024) {
      float w[4][8], bias[8];
#pragma unroll
      for (int j = 0; j < 4; ++j) {
        const float4 w0 = *(const float4*)(cw + j * 1024 + n), w1 = *(const float4*)(cw + j * 1024 + n + 4);
        w[j][0] = w0.x; w[j][1] = w0.y; w[j][2] = w0.z; w[j][3] = w0.w; w[j][4] = w1.x; w[j][5] = w1.y; w[j][6] = w1.z; w[j][7] = w1.w;
      }
      {
        const float4 b0 = *(const float4*)(cb + n), b1 = *(const float4*)(cb + n + 4);
        bias[0] = b0.x; bias[1] = b0.y; bias[2] = b0.z; bias[3] = b0.w; bias[4] = b1.x; bias[5] = b1.y; bias[6] = b1.z; bias[7] = b1.w;
      }
#pragma unroll
      for (int k = 0; k < 8; ++k) {
        const int row = (tid >> 4) + 32 * k;
        if (row >= olo && row < ohi) {
          float y[8];
#pragma unroll
          for (int e = 0; e < 8; ++e) y[e] = bias[e];
#pragma unroll
          for (int j = 0; j < 4; ++j) {
            const int rr = row - 2 + j;
            if (rr >= vlo && rr < vhi) {
              float x[8]; ld8(Cs, rr, col8, x);
#pragma unroll
              for (int e = 0; e < 8; ++e) y[e] += w[j][e] * x[e];
            }
          }
          *(uint4*)(xc + (size_t)(m0 + row) * 1024 + n) = pack8(y);
        }
      }
    } else {
#pragma unroll
      for (int k = 0; k < 8; ++k) {
        const int row = (tid >> 4) + 32 * k;
        if (row >= olo && row < ohi) {
          float v[8]; ld8(Cs, row, col8, v);
#pragma unroll
          for (int e = 0; e < 8; ++e) v[e] = silu_f(v[e]);
          *(uint4*)(sg + (size_t)(m0 + row) * 1024 + n - 1024) = pack8(v);
        }
      }
    }
  }
};

struct EpiLruGate {
  const bfu* xc; bfu* la; bfu* bb; const float* b_r; const float* b_i; const float* spl;
  DI void operator()(int m0, int n0, int nt, const float* Cs, int tid) const {
#pragma unroll
    for (int k = 0; k < 4; ++k) {
      const int c = tid + 512 * k, row = c >> 3, g = (c >> 2) & 1, c4 = c & 3;
      const int grp = (n0 >> 6) + g;
      const int cg8 = grp & 7, d = (grp >> 3) & 1, nblk = grp >> 4;
      const int ch = nblk * 256 + cg8 * 32 + c4 * 8;
      float vr[8], vi[8], xv[8];
      ld8(Cs, row, g * 64 + c4 * 8, vr);
      ld8(Cs, row, g * 64 + 32 + c4 * 8, vi);
      const int m = m0 + row;
      unpack8(*(const uint4*)(xc + (size_t)m * 1024 + ch), xv);
      float lo[8], bo[8];
#pragma unroll
      for (int e = 0; e < 8; ++e) {
        const float r = sigmoid_f(vr[e] + b_r[d * 1024 + ch + e]);
        const float ig = sigmoid_f(vi[e] + b_i[d * 1024 + ch + e]);
        const float loga = -8.0f * r * spl[d * 1024 + ch + e];
        lo[e] = loga;
        bo[e] = __builtin_amdgcn_sqrtf(one_minus_exp(2.0f * loga)) * (ig * xv[e]);
      }
      *(uint4*)(la + ((size_t)m * 2 + d) * 1024 + ch) = pack8(lo);
      *(uint4*)(bb + ((size_t)m * 2 + d) * 1024 + ch) = pack8(bo);
    }
  }
};

DI void mod_phase(const Params& p, float* mod, char* smem) {
  float* sc = (float*)smem;
  float* red = sc + 3 * 1024;
  const int tid = opaque_tid(), lane = tid & 63, wid = tid >> 6;
  for (int i = tid; i < 3 * 1024; i += NTHR) {
    const int v = i >> 10, k = i & 1023;
    const float cv = v < 2 ? p.c[v * 1024 + k] : p.c_ctx[k];
    sc[i] = silu_f(cv);
  }
  __syncthreads();
  for (int t = opaque_bid(); t < 192; t += gridDim.x) {
    const int l = t / 48, n = (t % 48) * 64 + lane;
    const float* w = p.mod_w + (size_t)l * 1024 * 3072 + n;
    float a0 = 0.f, a1 = 0.f, a2 = 0.f;
    for (int k0 = wid * 128; k0 < wid * 128 + 128; k0 += 16) {
      float wv[16];
#pragma unroll
      for (int u = 0; u < 16; ++u) wv[u] = w[(size_t)(k0 + u) * 3072];
#pragma unroll
      for (int u = 0; u < 16; ++u) { a0 += sc[k0 + u] * wv[u]; a1 += sc[1024 + k0 + u] * wv[u]; a2 += sc[2048 + k0 + u] * wv[u]; }
    }
    red[(wid * 3 + 0) * 64 + lane] = a0; red[(wid * 3 + 1) * 64 + lane] = a1; red[(wid * 3 + 2) * 64 + lane] = a2;
    __syncthreads();
    if (tid < 192) {
      const int v = tid >> 6;
      float s = 0.f;
      for (int w8 = 0; w8 < 8; ++w8) s += red[(w8 * 3 + v) * 64 + lane];
      mod[((size_t)l * 3 + v) * 3072 + n] = s + p.mod_b[l * 3072 + n];
    }
    __syncthreads();
  }
}

DI void norm_phase(const float* xsrc, const float* ctxres, const float* ng, const float* modl, bool colmajor, bfu* h) {
  const int tid = opaque_tid(), lane = tid & 63, wid = tid >> 6;
  const int nw = gridDim.x * 8;
  for (int m0 = opaque_bid() * 8 + wid; m0 < M; m0 += 2 * nw) {
    const float* src[2]; int vv[2]; bool ok[2];
    float4 xv[2][4];
#pragma unroll
    for (int u = 0; u < 2; ++u) {
      const int m = m0 + u * nw;
      ok[u] = m < M;
      const int rr = res_row(ok[u] ? m : m0, colmajor);
      if (rr >= 0) { src[u] = xsrc + (size_t)rr * 1024; vv[u] = rr >> 13; } else { src[u] = ctxres + (size_t)(-rr - 1) * 1024; vv[u] = 2; }
#pragma unroll
      for (int i = 0; i < 4; ++i) xv[u][i] = *(const float4*)(src[u] + i * 256 + lane * 4);
    }
#pragma unroll
    for (int u = 0; u < 2; ++u) {
      float ss = 0.f;
#pragma unroll
      for (int i = 0; i < 4; ++i) ss += xv[u][i].x * xv[u][i].x + xv[u][i].y * xv[u][i].y + xv[u][i].z * xv[u][i].z + xv[u][i].w * xv[u][i].w;
      ss = wave_sum(ss);
      const float rstd = rsqrtf(ss * (1.0f / 1024.0f) + 1e-6f);
      const float* shift = modl + vv[u] * 3072;
      const float* scale = shift + 1024;
      if (ok[u]) {
#pragma unroll
        for (int i = 0; i < 4; ++i) {
          const int k = i * 256 + lane * 4;
          const float4 g = *(const float4*)(ng + k), sc = *(const float4*)(scale + k), sh = *(const float4*)(shift + k);
          uint2 ov = {pack2(xv[u][i].x * rstd * g.x * (1.f + sc.x) + sh.x, xv[u][i].y * rstd * g.y * (1.f + sc.y) + sh.y),
                      pack2(xv[u][i].z * rstd * g.z * (1.f + sc.z) + sh.z, xv[u][i].w * rstd * g.w * (1.f + sc.w) + sh.w)};
          *(uint2*)(h + (size_t)(m0 + u * nw) * 1024 + k) = ov;
        }
      }
    }
  }
}

DI void final_norm_phase(float* x, const float* fg) {
  const int lane = opaque_tid() & 63, wid = opaque_tid() >> 6;
  for (int r = opaque_bid() * 8 + wid; r < 2 * SEQ; r += gridDim.x * 8) {
    float* src = x + (size_t)r * 1024;
    float4 xv[4];
    float ss = 0.f;
#pragma unroll
    for (int i = 0; i < 4; ++i) {
      xv[i] = *(const float4*)(src + i * 256 + lane * 4);
      ss += xv[i].x * xv[i].x + xv[i].y * xv[i].y + xv[i].z * xv[i].z + xv[i].w * xv[i].w;
    }
    ss = wave_sum(ss);
    const float rstd = rsqrtf(ss * (1.0f / 1024.0f) + 1e-6f);
#pragma unroll
    for (int i = 0; i < 4; ++i) {
      const int k = i * 256 + lane * 4;
      const float4 g = *(const float4*)(fg + k);
      float4 o = {xv[i].x * rstd * g.x, xv[i].y * rstd * g.y, xv[i].z * rstd * g.z, xv[i].w * rstd * g.w};
      *(float4*)(src + k) = o;
    }
  }
}

DI void ld2(const bfu* ptr, float& a, float& b) {
  const uint32_t v = *(const uint32_t*)ptr;
  a = __uint_as_float(v << 16);
  b = __uint_as_float(v & 0xffff0000u);
}

DI void gdn_conv_phase(bfu* proj, const bfu* halo, const float* cw) {
  const int lane = opaque_tid() & 63, wid = opaque_tid() >> 6;
  for (int task = opaque_bid() * 8 + wid; task < 264 * 32; task += gridDim.x * 8) {
    const int T = task >> 5, u_ = task & 31;
    const int ch = u_ * 128 + lane * 2;
    const int p0 = (T % NCH) * 64;
    const bool sstart = (p0 == 0 || p0 == CTX), send = (p0 + 64 == CTX || p0 + 64 == TPB);
    float w00 = cw[0 * 4096 + ch], w01 = cw[0 * 4096 + ch + 1];
    float w10 = cw[1 * 4096 + ch], w11 = cw[1 * 4096 + ch + 1];
    float w20 = cw[2 * 4096 + ch], w21 = cw[2 * 4096 + ch + 1];
    float w30 = cw[3 * 4096 + ch], w31 = cw[3 * 4096 + ch + 1];
    float xm2a = 0.f, xm2b = 0.f, xm1a = 0.f, xm1b = 0.f, x0a, x0b, xp1a, xp1b;
    if (!sstart) { ld2(halo + ((size_t)T * 3 + 0) * 4096 + ch, xm2a, xm2b); ld2(halo + ((size_t)T * 3 + 1) * 4096 + ch, xm1a, xm1b); }
    bfu* row = proj + (size_t)T * 64 * 4096 + ch;
    ld2(row, x0a, x0b);
    for (int t8 = 0; t8 < 64; t8 += 16) {
      uint32_t nx[16];
#pragma unroll
      for (int u = 0; u < 16; ++u) {
        const int tt = t8 + u;
        if (tt < 63) nx[u] = *(const uint32_t*)(row + (size_t)(tt + 1) * 4096);
        else nx[u] = send ? 0u : *(const uint32_t*)(halo + ((size_t)T * 3 + 2) * 4096 + ch);
      }
#pragma unroll
      for (int u = 0; u < 16; ++u) {
        const int tt = t8 + u;
        xp1a = __uint_as_float(nx[u] << 16); xp1b = __uint_as_float(nx[u] & 0xffff0000u);
        float y0 = w00 * xm2a + w10 * xm1a + w20 * x0a + w30 * xp1a;
        float y1 = w01 * xm2b + w11 * xm1b + w21 * x0b + w31 * xp1b;
        y0 = silu_f(y0); y1 = silu_f(y1);
        if (u_ < 16) {
          const float ss = wave_sum(y0 * y0 + y1 * y1);
          float sc = rsqrtf(ss + 1e-6f);
          if (u_ < 8) sc *= 0.08838834764831845f;
          y0 *= sc; y1 *= sc;
        }
        *(uint32_t*)(row + (size_t)tt * 4096) = pack2(y0, y1);
        xm2a = xm1a; xm2b = xm1b; xm1a = x0a; xm1b = x0b; x0a = xp1a; x0b = xp1b;
      }
    }
  }
}

using f32x16 = __attribute__((ext_vector_type(16))) float;
#define MFMA32(a, b, c) __builtin_amdgcn_mfma_f32_32x32x16_bf16((a), (b), (c), 0, 0, 0)
constexpr int SEG_STRIDE = 28800;
constexpr int WF_OFF = 0, KDF_OFF = 8192, QKF_OFF = 16384, UF_OFF = 20480, EG_OFF = 28672;
constexpr int SEG_STEPS = 8;
constexpr int PREP_HALF_LDS = 75776;

DI bf16x8 frag8(const bfu* p) {
  const uint2 a = *(const uint2*)p, b = *(const uint2*)(p + 4);
  uint4 v = {a.x, a.y, b.x, b.y};
  return __builtin_bit_cast(bf16x8, v);
}
DI int crow(int i, int h) { return (i & 3) + 8 * (i >> 2) + 4 * h; }

DI void gdn_prep(const bfu* __restrict__ proj, const float* __restrict__ gab, const float* __restrict__ a_log,
                 const float* __restrict__ dt_bias, bfu* __restrict__ seg, float* __restrict__ glbuf, int s0, int s1, char* smem,
                 unsigned* prog, unsigned need) {
  const int ntasks = 64 * (s1 - s0);
  for (int pt = opaque_bid(); pt * 2 < ntasks; pt += gridDim.x) {
    const int tid = opaque_tid(), half = tid >> 8, ht = tid & 255, hw = ht >> 6, lane = tid & 63;
    const int r = lane & 31, h = lane >> 5;
    char* base = smem + half * PREP_HALF_LDS;
    bfu* qs = (bfu*)base;
    bfu* ks = qs + 64 * 136;
    bfu* kT = ks + 64 * 136;
    bfu* vT = kT + 128 * 68;
    float* gs = (float*)(vT + 128 * 68);
    float* Lm = (float*)qs;
    bfu* T1 = ks;
    bfu* T2 = ks + 64 * 68;
    const int tsk0 = pt * 2 + half;
    const bool valid = tsk0 < ntasks;
    const int tsk = valid ? tsk0 : ntasks - 1;
    const int slot = tsk >> 6, chain = tsk & 63, step = s0 + slot;
    const int b = chain >> 5, dir = (chain >> 4) & 1, hh = chain & 15, qh = hh >> 1;
    const int m0 = chain_row(b, dir, step * 64);
    const int sgn = dir == 0 ? 1 : -1;
    bfu* segp = seg + ((size_t)slot * 64 + chain) * SEG_STRIDE;
    if (need != 0u && ht == 192) { unsigned sp = 0; while (xb_ld(prog + 8 * chain) < need) { __builtin_amdgcn_s_sleep(1); if (++sp > (1u << 20)) break; } }
    if (hw == 0) {
      const int m = m0 + sgn * lane;
      const float rawg = gab[(size_t)m * 64 + dir * 32 + hh], rawb = gab[(size_t)m * 64 + dir * 32 + 16 + hh];
      const float g = -__expf(a_log[dir * 16 + hh]) * softplus_f(rawg + dt_bias[dir * 16 + hh]);
      float cs = g;
#pragma unroll
      for (int o = 1; o < 64; o <<= 1) { const float t = __shfl_up(cs, o); if (lane >= o) cs += t; }
      const float gl = __shfl(cs, 63);
      gs[lane] = cs; gs[64 + lane] = sigmoid_f(rawb); gs[128 + lane] = __expf(cs); gs[192 + lane] = __expf(gl - cs);
      if (lane == 0 && valid) glbuf[chain * NCH + step] = __expf(gl);
    }
#pragma unroll
    for (int it = 0; it < 4; ++it) {
      const int c = (ht & 15) + 16 * hw, col8 = (((ht >> 4) & 3) + 4 * it) * 8;
      const bfu* rowp = proj + (size_t)(m0 + sgn * c) * 4096;
      const uint4 qv = *(const uint4*)(rowp + qh * 128 + col8);
      const uint4 kv = *(const uint4*)(rowp + 1024 + qh * 128 + col8);
      const uint4 vv = *(const uint4*)(rowp + 2048 + hh * 128 + col8);
      *(uint4*)(qs + c * 136 + col8) = qv;
      *(uint4*)(ks + c * 136 + col8) = kv;
      const uint32_t kw[4] = {kv.x, kv.y, kv.z, kv.w}, vw[4] = {vv.x, vv.y, vv.z, vv.w};
#pragma unroll
      for (int i = 0; i < 4; ++i) {
        kT[(col8 + 2 * i) * 68 + c] = (bfu)(kw[i] & 0xffffu);
        kT[(col8 + 2 * i + 1) * 68 + c] = (bfu)(kw[i] >> 16);
        vT[(col8 + 2 * i) * 68 + c] = (bfu)(vw[i] & 0xffffu);
        vT[(col8 + 2 * i + 1) * 68 + c] = (bfu)(vw[i] >> 16);
      }
    }
    __syncthreads();
    if (hw == 0 && valid) ((float*)(segp + EG_OFF))[lane] = gs[128 + lane];
    const int ti = hw >> 1, tj = hw & 1;
    f32x16 kkacc, qkacc;
#pragma unroll
    for (int i = 0; i < 16; ++i) { kkacc[i] = 0.f; qkacc[i] = 0.f; }
#pragma unroll
    for (int k8 = 0; k8 < 8; ++k8) {
      const bf16x8 a = *(const bf16x8*)(ks + (32 * ti + r) * 136 + 16 * k8 + 8 * h);
      const bf16x8 bk = *(const bf16x8*)(ks + (32 * tj + r) * 136 + 16 * k8 + 8 * h);
      const bf16x8 bq = *(const bf16x8*)(qs + (32 * tj + r) * 136 + 16 * k8 + 8 * h);
      kkacc = MFMA32(a, bk, kkacc);
      qkacc = MFMA32(a, bq, qkacc);
    }
    __syncthreads();
#pragma unroll
    for (int i = 0; i < 16; ++i) {
      const int c = 32 * ti + crow(i, h), sidx = 32 * tj + r;
      Lm[c * 64 + sidx] = (sidx < c) ? gs[64 + c] * kkacc[i] * __expf(gs[c] - gs[sidx]) : 0.f;
    }
#pragma unroll
    for (int q = 0; q < 4; ++q) {
      const int c = 32 * tj + r;
      float vals[4];
#pragma unroll
      for (int t = 0; t < 4; ++t) {
        const int sidx = 32 * ti + 8 * q + 4 * h + t;
        vals[t] = (sidx <= c) ? qkacc[4 * q + t] * __expf(gs[c] - gs[sidx]) : 0.f;
      }
      const int k4 = 2 * ti + (q >> 1), hp = q & 1;
      uint2 ov = {pack2(vals[0], vals[1]), pack2(vals[2], vals[3])};
      if (valid) *(uint2*)(segp + QKF_OFF + ((tj * 4 + k4) * 64 + hp * 32 + r) * 8 + 4 * h) = ov;
    }
    __syncthreads();
    bfu* TB = (bfu*)(gs + 256);
    bfu* TA = TB + 32 * 40;
    const int wa = half, wb = half ^ 1;
    if (hw == wa || hw == wb) {
      const int ob = (hw == wa) ? 0 : 32;
      f32x2_t t2[16];
#pragma unroll
      for (int i = 0; i < 16; ++i) t2[i] = f32x2_t{0.f, 0.f};
      int r_o = r;
      asm volatile("" : "+v"(r_o));
#pragma unroll
      for (int i = 0; i < 32; ++i) {
        f32x2_t a0 = {0.f, 0.f}, a1 = {0.f, 0.f};
#pragma unroll
        for (int q = 0; q < (i + 3) / 4; ++q) {
          const float4 l4 = *(const float4*)(Lm + (ob + i) * 64 + ob + 4 * q);
          a0 = __builtin_elementwise_fma(f32x2_t{l4.x, l4.y}, t2[2 * q], a0);
          a1 = __builtin_elementwise_fma(f32x2_t{l4.z, l4.w}, t2[2 * q + 1], a1);
        }
        const float acc = ((i == r_o) ? 1.f : 0.f) - ((a0[0] + a0[1]) + (a1[0] + a1[1]));
        t2[i >> 1][i & 1] = acc;
        if ((i & 15) == 15) __builtin_amdgcn_sched_barrier(0);
      }
      const float s2 = gs[64 + ob + r], s1v = s2 * gs[128 + ob + r];
      if (h == 0) {
#pragma unroll
        for (int i = 0; i < 32; ++i) {
          const uint32_t pk = pack2(t2[i >> 1][i & 1] * s1v, t2[i >> 1][i & 1] * s2);
          T1[(ob + i) * 68 + ob + r] = (bfu)(pk & 0xffffu);
          T2[(ob + i) * 68 + ob + r] = (bfu)(pk >> 16);
        }
      } else if (hw == wa) {
#pragma unroll
        for (int g = 0; g < 4; ++g) {
          uint4 v = {pack2(t2[4 * g][0], t2[4 * g][1]), pack2(t2[4 * g + 1][0], t2[4 * g + 1][1]),
                     pack2(t2[4 * g + 2][0], t2[4 * g + 2][1]), pack2(t2[4 * g + 3][0], t2[4 * g + 3][1])};
          *(uint4*)(TB + r * 40 + 8 * g) = v;
        }
      } else {
#pragma unroll
        for (int i = 0; i < 32; ++i) {
          TA[i * 40 + r] = f2bf(t2[i >> 1][i & 1]);
          T1[i * 68 + 32 + r] = 0;
          T2[i * 68 + 32 + r] = 0;
        }
      }
    } else {
      for (int idx = (hw - 2) * 64 + lane; idx < 1024; idx += 128) {
        const int l_ = idx & 63, k4 = (idx >> 6) & 3, dkb = idx >> 8;
        const int dk = 32 * dkb + (l_ & 31), cb = 16 * k4 + 8 * (l_ >> 5);
        const uint2 v0 = *(const uint2*)(kT + dk * 68 + cb), v1 = *(const uint2*)(kT + dk * 68 + cb + 4);
        const float* ek = gs + 192 + cb;
        uint4 ov;
        ov.x = pack2(__uint_as_float(v0.x << 16) * ek[0], __uint_as_float(v0.x & 0xffff0000u) * ek[1]);
        ov.y = pack2(__uint_as_float(v0.y << 16) * ek[2], __uint_as_float(v0.y & 0xffff0000u) * ek[3]);
        ov.z = pack2(__uint_as_float(v1.x << 16) * ek[4], __uint_as_float(v1.x & 0xffff0000u) * ek[5]);
        ov.w = pack2(__uint_as_float(v1.y << 16) * ek[6], __uint_as_float(v1.y & 0xffff0000u) * ek[7]);
        if (valid) *(uint4*)(segp + KDF_OFF + idx * 8) = ov;
      }
    }
    __syncthreads();
    if (hw == wa) {
      f32x16 X, Y;
#pragma unroll
      for (int i = 0; i < 16; ++i) { X[i] = 0.f; Y[i] = 0.f; }
#pragma unroll
      for (int k2 = 0; k2 < 2; ++k2) {
        const float4 l0 = *(const float4*)(Lm + (32 + r) * 64 + 16 * k2 + 8 * h), l1 = *(const float4*)(Lm + (32 + r) * 64 + 16 * k2 + 8 * h + 4);
        const uint4 av = {pack2(l0.x, l0.y), pack2(l0.z, l0.w), pack2(l1.x, l1.y), pack2(l1.z, l1.w)};
        const bf16x8 bt = *(const bf16x8*)(TB + r * 40 + 16 * k2 + 8 * h);
        X = MFMA32(__builtin_bit_cast(bf16x8, av), bt, X);
      }
#pragma unroll
      for (int s2i = 0; s2i < 2; ++s2i) {
        const uint4 xv = {pack2(X[8 * s2i], X[8 * s2i + 1]), pack2(X[8 * s2i + 2], X[8 * s2i + 3]),
                          pack2(X[8 * s2i + 4], X[8 * s2i + 5]), pack2(X[8 * s2i + 6], X[8 * s2i + 7])};
        const uint2 a_lo = *(const uint2*)(TA + r * 40 + 16 * s2i + 4 * h), a_hi = *(const uint2*)(TA + r * 40 + 16 * s2i + 8 + 4 * h);
        const uint4 av = {a_lo.x, a_lo.y, a_hi.x, a_hi.y};
        Y = MFMA32(__builtin_bit_cast(bf16x8, av), __builtin_bit_cast(bf16x8, xv), Y);
      }
      const float c2 = gs[64 + r], c1 = c2 * gs[128 + r];
#pragma unroll
      for (int i = 0; i < 16; ++i) {
        const uint32_t pk = pack2(-Y[i] * c1, -Y[i] * c2);
        T1[(32 + crow(i, h)) * 68 + r] = (bfu)(pk & 0xffffu);
        T2[(32 + crow(i, h)) * 68 + r] = (bfu)(pk >> 16);
      }
    }
    __syncthreads();
    {
      f32x16 wa0, wa1;
#pragma unroll
      for (int i = 0; i < 16; ++i) { wa0[i] = 0.f; wa1[i] = 0.f; }
#pragma unroll
      for (int k4 = 0; k4 < 4; ++k4) {
        const int ko = 16 * k4 + 8 * h;
        const bf16x8 ak = frag8(kT + (32 * hw + r) * 68 + ko);
        const bf16x8 bt0 = frag8(T1 + r * 68 + ko), bt1 = frag8(T1 + (32 + r) * 68 + ko);
        wa0 = MFMA32(ak, bt0, wa0);
        wa1 = MFMA32(ak, bt1, wa1);
      }
      if (valid) {
#pragma unroll
        for (int q = 0; q < 4; ++q) {
          const int k8 = 2 * hw + (q >> 1), hp = q & 1;
          uint2 o0 = {pack2(-wa0[4 * q], -wa0[4 * q + 1]), pack2(-wa0[4 * q + 2], -wa0[4 * q + 3])};
          uint2 o1 = {pack2(-wa1[4 * q], -wa1[4 * q + 1]), pack2(-wa1[4 * q + 2], -wa1[4 * q + 3])};
          *(uint2*)(segp + WF_OFF + ((0 * 8 + k8) * 64 + hp * 32 + r) * 8 + 4 * h) = o0;
          *(uint2*)(segp + WF_OFF + ((1 * 8 + k8) * 64 + hp * 32 + r) * 8 + 4 * h) = o1;
        }
      }
    }
    {
      f32x16 ua0, ua1;
#pragma unroll
      for (int i = 0; i < 16; ++i) { ua0[i] = 0.f; ua1[i] = 0.f; }
#pragma unroll
      for (int k4 = 0; k4 < 4; ++k4) {
        const int ko = 16 * k4 + 8 * h;
        const bf16x8 at0 = frag8(T2 + r * 68 + ko), at1 = frag8(T2 + (32 + r) * 68 + ko);
        const bf16x8 bv = frag8(vT + (32 * hw + r) * 68 + ko);
        ua0 = MFMA32(at0, bv, ua0);
        ua1 = MFMA32(at1, bv, ua1);
      }
      if (valid) {
        uint4 u;
        bfu* up0 = segp + UF_OFF + ((hw * 2 + 0) * 64 + lane) * 16;
        bfu* up1 = segp + UF_OFF + ((hw * 2 + 1) * 64 + lane) * 16;
        u = {pack2(ua0[0], ua0[1]), pack2(ua0[2], ua0[3]), pack2(ua0[4], ua0[5]), pack2(ua0[6], ua0[7])}; *(uint4*)up0 = u;
        u = {pack2(ua0[8], ua0[9]), pack2(ua0[10], ua0[11]), pack2(ua0[12], ua0[13]), pack2(ua0[14], ua0[15])}; *(uint4*)(up0 + 8) = u;
        u = {pack2(ua1[0], ua1[1]), pack2(ua1[2], ua1[3]), pack2(ua1[4], ua1[5]), pack2(ua1[6], ua1[7])}; *(uint4*)up1 = u;
        u = {pack2(ua1[8], ua1[9]), pack2(ua1[10], ua1[11]), pack2(ua1[12], ua1[13]), pack2(ua1[14], ua1[15])}; *(uint4*)(up1 + 8) = u;
      }
    }
    __syncthreads();
  }
}

struct ScanOps { bf16x8 af[8]; bf16x8 b4[4]; uint4 u0, u1; float gl; float egv; };
DI void scan_load(ScanOps& q, const bfu* __restrict__ sp, const float* __restrict__ glbuf, const bfu* __restrict__ proj, int w, int lane, int sl,
                  int chain, int step) {
  if (w < 4) {
    const int mb = w & 1;
    if (w < 2) {
      const bfu* ap = sp + WF_OFF + (mb * 8 * 64 + lane) * 8;
#pragma unroll
      for (int k8 = 0; k8 < 8; ++k8) q.af[k8] = *(const bf16x8*)(ap + k8 * 512);
      const bfu* up = sp + UF_OFF + ((sl * 2 + mb) * 64 + lane) * 16;
      q.u0 = *(const uint4*)up; q.u1 = *(const uint4*)(up + 8);
    } else {
      const int b = chain >> 5, dir = (chain >> 4) & 1, qh = (chain & 15) >> 1;
      const int m = chain_row(b, dir, step * 64 + 32 * mb + (lane & 31));
      const bfu* ap = proj + (size_t)m * 4096 + qh * 128 + 8 * (lane >> 5);
#pragma unroll
      for (int k8 = 0; k8 < 8; ++k8) q.af[k8] = *(const bf16x8*)(ap + 16 * k8);
      q.egv = ((const float*)(sp + EG_OFF))[lane];
      const bfu* qp = sp + QKF_OFF + (mb * 4 * 64 + lane) * 8;
#pragma unroll
      for (int k4 = 0; k4 < 4; ++k4) q.b4[k4] = *(const bf16x8*)(qp + k4 * 512);
    }
  } else {
    const bfu* kp = sp + KDF_OFF + ((w - 4) * 4 * 64 + lane) * 8;
#pragma unroll
    for (int k4 = 0; k4 < 4; ++k4) q.b4[k4] = *(const bf16x8*)(kp + k4 * 512);
    q.gl = glbuf[chain * NCH + step];
  }
}

DI bfu* o_piece_ptr(bfu* o, bfu* octx2, int b, int dir, int hh, int sl, int step, int c, int piece) {
  const int m = chain_row(b, dir, step * 64 + c);
  const int col = hh * 128 + 32 * sl + piece * 8;
  if (step < 4 && dir == 1) return octx2 + (size_t)(b * CTX + (m - b * TPB)) * 2048 + col;
  return o + (size_t)m * 2048 + col;
}

DI void gdn_scan_seg(const bfu* __restrict__ seg, const float* __restrict__ glbuf, const bfu* __restrict__ proj, int s0, int s1, float* sstate,
                     bfu* o, bfu* octx2, char* smem) {
  bfu* Sb = (bfu*)smem;
  bfu* Vn = Sb + 32 * 136;
  bfu* Ot = Vn + 32 * 68;
  float* Eg = (float*)(Ot + 2 * 32 * 40);
  const int tid = opaque_tid(), w = tid >> 6, lane = tid & 63, r = lane & 31, h = lane >> 5;
  const int bid = opaque_bid();
  const int chain = (bid & 7) * 8 + (bid >> 5), sl = (bid >> 3) & 3;
  const int b = chain >> 5, dir = (chain >> 4) & 1, hh = chain & 15;
  f32x16 Sacc;
  float* sst = sstate + ((size_t)bid * 256 + (tid & 255)) * 16;
  if (s0 == 0) {
#pragma unroll
    for (int i = 0; i < 16; ++i) Sacc[i] = 0.f;
  } else if (w >= 4) {
#pragma unroll
    for (int i = 0; i < 4; ++i) { const float4 v = *(const float4*)(sst + 4 * i); Sacc[4 * i] = v.x; Sacc[4 * i + 1] = v.y; Sacc[4 * i + 2] = v.z; Sacc[4 * i + 3] = v.w; }
  }
  ScanOps cur;
  scan_load(cur, seg + (size_t)chain * SEG_STRIDE, glbuf, proj, w, lane, sl, chain, s0);
  for (int step = s0; step < s1; ++step) {
    ScanOps nxt;
    if (step + 1 < s1) scan_load(nxt, seg + ((size_t)(step + 1 - s0) * 64 + chain) * SEG_STRIDE, glbuf, proj, w, lane, sl, chain, step + 1);
    uint4 oldo0 = {0, 0, 0, 0}, oldo1 = {0, 0, 0, 0};
    if (step >= 68 && (w == 2 || w == 3)) {
      oldo0 = *(const uint4*)o_piece_ptr(o, octx2, b, dir, hh, sl, step, 32 * (w - 2) + (lane >> 2), lane & 3);
      oldo1 = *(const uint4*)o_piece_ptr(o, octx2, b, dir, hh, sl, step, 32 * (w - 2) + (lane >> 2) + 16, lane & 3);
    }
    if (w == 2) Eg[lane] = cur.egv;
    if (w >= 4) {
#pragma unroll
      for (int q = 0; q < 4; ++q) {
        uint2 ov = {pack2(Sacc[4 * q], Sacc[4 * q + 1]), pack2(Sacc[4 * q + 2], Sacc[4 * q + 3])};
        *(uint2*)(Sb + r * 136 + 32 * (w - 4) + 8 * q + 4 * h) = ov;
      }
    }
    __syncthreads();
    f32x16 acc;
    if (w < 4) {
      if (w < 2) {
        const uint32_t uw[8] = {cur.u0.x, cur.u0.y, cur.u0.z, cur.u0.w, cur.u1.x, cur.u1.y, cur.u1.z, cur.u1.w};
#pragma unroll
        for (int i = 0; i < 8; ++i) { acc[2 * i] = __uint_as_float(uw[i] << 16); acc[2 * i + 1] = __uint_as_float(uw[i] & 0xffff0000u); }
      } else {
#pragma unroll
        for (int i = 0; i < 16; ++i) acc[i] = 0.f;
      }
#pragma unroll
      for (int k8 = 0; k8 < 8; ++k8) {
        const bf16x8 bs = *(const bf16x8*)(Sb + r * 136 + 16 * k8 + 8 * h);
        acc = MFMA32(cur.af[k8], bs, acc);
      }
      if (w < 2) {
#pragma unroll
        for (int q = 0; q < 4; ++q) {
          uint2 ov = {pack2(acc[4 * q], acc[4 * q + 1]), pack2(acc[4 * q + 2], acc[4 * q + 3])};
          *(uint2*)(Vn + r * 68 + 32 * w + 8 * q + 4 * h) = ov;
        }
      } else {
#pragma unroll
        for (int q = 0; q < 4; ++q) {
          const float4 e4 = *(const float4*)(Eg + 32 * (w & 1) + 8 * q + 4 * h);
          acc[4 * q] *= e4.x; acc[4 * q + 1] *= e4.y; acc[4 * q + 2] *= e4.z; acc[4 * q + 3] *= e4.w;
        }
      }
    }
    __syncthreads();
    if (w >= 2) {
      bf16x8 bv[4];
#pragma unroll
      for (int k4 = 0; k4 < 4; ++k4) bv[k4] = frag8(Vn + r * 68 + 16 * k4 + 8 * h);
      if (w < 4) {
#pragma unroll
        for (int k4 = 0; k4 < 4; ++k4) acc = MFMA32(cur.b4[k4], bv[k4], acc);
        bfu* ot = Ot + (w - 2) * 32 * 40;
#pragma unroll
        for (int i = 0; i < 16; ++i) ot[crow(i, h) * 40 + r] = f2bf(acc[i]);
        __builtin_amdgcn_s_waitcnt(0xc07f);
        __builtin_amdgcn_wave_barrier();
#pragma unroll
        for (int u = 0; u < 2; ++u) {
          const int cl = (lane >> 2) + 16 * u, piece = lane & 3;
          const uint4 nv = *(const uint4*)(ot + cl * 40 + piece * 8);
          bfu* gp = o_piece_ptr(o, octx2, b, dir, hh, sl, step, 32 * (w - 2) + cl, piece);
          if (step < 68) *(uint4*)gp = nv;
          else {
            const uint4 ov = u == 0 ? oldo0 : oldo1;
            uint4 rv;
            rv.x = pack2(__uint_as_float(ov.x << 16) + __uint_as_float(nv.x << 16), __uint_as_float(ov.x & 0xffff0000u) + __uint_as_float(nv.x & 0xffff0000u));
            rv.y = pack2(__uint_as_float(ov.y << 16) + __uint_as_float(nv.y << 16), __uint_as_float(ov.y & 0xffff0000u) + __uint_as_float(nv.y & 0xffff0000u));
            rv.z = pack2(__uint_as_float(ov.z << 16) + __uint_as_float(nv.z << 16), __uint_as_float(ov.z & 0xffff0000u) + __uint_as_float(nv.z & 0xffff0000u));
            rv.w = pack2(__uint_as_float(ov.w << 16) + __uint_as_float(nv.w << 16), __uint_as_float(ov.w & 0xffff0000u) + __uint_as_float(nv.w & 0xffff0000u));
            *(uint4*)gp = rv;
          }
        }
      } else {
#pragma unroll
        for (int i = 0; i < 16; ++i) Sacc[i] *= cur.gl;
#pragma unroll
        for (int k4 = 0; k4 < 4; ++k4) Sacc = MFMA32(cur.b4[k4], bv[k4], Sacc);
      }
    }
    cur = nxt;
  }
  if (w >= 4) {
#pragma unroll
    for (int i = 0; i < 4; ++i) { float4 v = {Sacc[4 * i], Sacc[4 * i + 1], Sacc[4 * i + 2], Sacc[4 * i + 3]}; *(float4*)(sst + 4 * i) = v; }
  }
}

DI void gdn_chunked(const bfu* proj, const float* gab, const float* a_log, const float* dt_bias, bfu* seg, float* glbuf, bfu* o,
                    bfu* octx2, char* smem, const XcdBarrier& gbar, unsigned& lb_count) {
  float* sstate = glbuf + 16384;
  unsigned* prog = gbar.bar + 3520;
  const int bid = opaque_bid();
  const int my_chain = (bid & 7) * 8 + (bid >> 5);
  for (int s0 = 0; s0 < NCH;) {
    const int lim = s0 < 68 ? 68 : NCH;
    const int s1 = s0 + SEG_STEPS < lim ? s0 + SEG_STEPS : lim;
    gdn_prep(proj, gab, a_log, dt_bias, seg, glbuf, s0, s1, smem, prog, 4u * lb_count);
    xcd_barrier(gbar);
    gdn_scan_seg(seg, glbuf, proj, s0, s1, sstate, o, octx2, smem);
    asm volatile("s_waitcnt vmcnt(0)" ::: "memory");
    __syncthreads();
    if (opaque_tid() == 0) xb_add(prog + 8 * my_chain, 1u);
    lb_count += 1u;
    if (s1 >= NCH) xcd_barrier(gbar);
    s0 = s1;
  }
}

DI void gdn_post_phase(bfu* o, const bfu* octx2, const float* ng) {
  const int tid = opaque_tid(), lane = tid & 63, wid = tid >> 6;
  const int hl = lane >> 5, l32 = lane & 31;
  const float4 g = *(const float4*)(ng + l32 * 4);
  for (int m = opaque_bid() * 8 + wid; m < M; m += gridDim.x * 8) {
    const int b = m / TPB, p = m - b * TPB;
    bfu* orow = o + (size_t)m * 2048 + hl * 128 + l32 * 4;
    uint2 v[8], v2[8];
#pragma unroll
    for (int it = 0; it < 8; ++it) v[it] = *(const uint2*)(orow + it * 256);
    if (p < CTX) {
      const bfu* crow_ = octx2 + (size_t)(b * CTX + p) * 2048 + hl * 128 + l32 * 4;
#pragma unroll
      for (int it = 0; it < 8; ++it) v2[it] = *(const uint2*)(crow_ + it * 256);
    }
#pragma unroll
    for (int it = 0; it < 8; ++it) {
      float f0 = __uint_as_float(v[it].x << 16), f1 = __uint_as_float(v[it].x & 0xffff0000u);
      float f2 = __uint_as_float(v[it].y << 16), f3 = __uint_as_float(v[it].y & 0xffff0000u);
      if (p < CTX) {
        f0 += __uint_as_float(v2[it].x << 16); f1 += __uint_as_float(v2[it].x & 0xffff0000u);
        f2 += __uint_as_float(v2[it].y << 16); f3 += __uint_as_float(v2[it].y & 0xffff0000u);
      }
      float ss = f0 * f0 + f1 * f1 + f2 * f2 + f3 * f3;
#pragma unroll
      for (int off = 16; off >= 1; off >>= 1) ss += __shfl_xor(ss, off);
      const float rstd = rsqrtf(ss * (1.0f / 128.0f) + 1e-6f);
      uint2 ov = {pack2(f0 * rstd * g.x, f1 * rstd * g.y), pack2(f2 * rstd * g.z, f3 * rstd * g.w)};
      *(uint2*)(orow + it * 256) = ov;
    }
  }
}

DI void lru_conv_phase(const bfu* xb, const float* cw, const float* cb, bfu* xc) {
  const int total = M * 128;
  for (int it = opaque_bid() * NTHR + opaque_tid(); it < total; it += gridDim.x * NTHR) {
    const int m = it >> 7, c8 = (it & 127) * 8;
    const int b = m / TPB, p = m - b * TPB;
    const int lo = p < CTX ? 0 : CTX, hi = p < CTX ? CTX : TPB;
    const float4 cb0 = *(const float4*)(cb + c8), cb1 = *(const float4*)(cb + c8 + 4);
    float a0 = cb0.x, a1 = cb0.y, a2 = cb0.z, a3 = cb0.w, a4 = cb1.x, a5 = cb1.y, a6 = cb1.z, a7 = cb1.w;
#pragma unroll
    for (int j = 0; j < 4; ++j) {
      const int pp = p - 2 + j;
      if (pp >= lo && pp < hi) {
        const uint4 v = *(const uint4*)(xb + (size_t)(m - 2 + j) * 1024 + c8);
        const float4 w0 = *(const float4*)(cw + j * 1024 + c8), w1 = *(const float4*)(cw + j * 1024 + c8 + 4);
        a0 += w0.x * __uint_as_float(v.x << 16); a1 += w0.y * __uint_as_float(v.x & 0xffff0000u);
        a2 += w0.z * __uint_as_float(v.y << 16); a3 += w0.w * __uint_as_float(v.y & 0xffff0000u);
        a4 += w1.x * __uint_as_float(v.z << 16); a5 += w1.y * __uint_as_float(v.z & 0xffff0000u);
        a6 += w1.z * __uint_as_float(v.w << 16); a7 += w1.w * __uint_as_float(v.w & 0xffff0000u);
      }
    }
    uint4 o;
    o.x = (uint32_t)f2bf(a0) | ((uint32_t)f2bf(a1) << 16);
    o.y = (uint32_t)f2bf(a2) | ((uint32_t)f2bf(a3) << 16);
    o.z = (uint32_t)f2bf(a4) | ((uint32_t)f2bf(a5) << 16);
    o.w = (uint32_t)f2bf(a6) | ((uint32_t)f2bf(a7) << 16);
    *(uint4*)(xc + (size_t)m * 1024 + c8) = o;
  }
}

DI void lru_scan1(const bfu* la, const bfu* bb, float* cp, float* chh) {
  const int total = 2 * 2 * NCH * 512;
  for (int e = opaque_bid() * NTHR + opaque_tid(); e < total; e += gridDim.x * NTHR) {
    const int ch = (e & 511) * 2, r = e >> 9;
    const int j = r % NCH, bd = r / NCH, d = bd & 1, b = bd >> 1;
    float P0 = 1.f, P1 = 1.f, H0 = 0.f, H1 = 0.f;
    const int m0 = chain_row(b, d, j * 64);
    const long stride = d == 0 ? 2048 : -2048;
    const bfu* lp = la + ((size_t)m0 * 2 + d) * 1024 + ch;
    const bfu* bp = bb + ((size_t)m0 * 2 + d) * 1024 + ch;
    for (int t8 = 0; t8 < 64; t8 += 16) {
      uint32_t lv[16], bv[16];
#pragma unroll
      for (int u = 0; u < 16; ++u) { lv[u] = *(const uint32_t*)(lp + (t8 + u) * stride); bv[u] = *(const uint32_t*)(bp + (t8 + u) * stride); }
#pragma unroll
      for (int u = 0; u < 16; ++u) {
        const float a0 = __expf(__uint_as_float(lv[u] << 16)), a1 = __expf(__uint_as_float(lv[u] & 0xffff0000u));
        P0 *= a0; P1 *= a1;
        H0 = a0 * H0 + __uint_as_float(bv[u] << 16); H1 = a1 * H1 + __uint_as_float(bv[u] & 0xffff0000u);
      }
    }
    const size_t oi = (size_t)r * 1024 + ch;
    *(float2*)(cp + oi) = float2{P0, P1};
    *(float2*)(chh + oi) = float2{H0, H1};
  }
}
DI void lru_scan2(const float* cp, const float* chh, float* ci, char* smem) {
  float* gp = (float*)smem;
  float* gh = gp + 12 * 32;
  const int tid = opaque_tid();
  const int g = tid >> 5, cl = tid & 31;
  for (int task = opaque_bid(); task < 4 * 32; task += gridDim.x) {
    const int bd = task >> 5, ch = (task & 31) * 32 + cl;
    float pv[11], hv[11];
    if (g < 12) {
#pragma unroll
      for (int u = 0; u < 11; ++u) { const size_t idx = ((size_t)bd * NCH + g * 11 + u) * 1024 + ch; pv[u] = cp[idx]; hv[u] = chh[idx]; }
      float P = 1.f, H = 0.f;
#pragma unroll
      for (int u = 0; u < 11; ++u) { H = pv[u] * H + hv[u]; P *= pv[u]; }
      gp[g * 32 + cl] = P; gh[g * 32 + cl] = H;
    }
    __syncthreads();
    if (g < 12) {
      float carry = 0.f;
      for (int q = 0; q < g; ++q) carry = gp[q * 32 + cl] * carry + gh[q * 32 + cl];
#pragma unroll
      for (int u = 0; u < 11; ++u) {
        ci[((size_t)bd * NCH + g * 11 + u) * 1024 + ch] = carry;
        carry = pv[u] * carry + hv[u];
      }
    }
    __syncthreads();
  }
}
DI void lru_scan3(const bfu* la, const bfu* bb, const float* ci, const bfu* sg, bfu* y) {
  const int total = 2 * NCH * 512;
  for (int e = opaque_bid() * NTHR + opaque_tid(); e < total; e += gridDim.x * NTHR) {
    const int ch = (e & 511) * 2, r = e >> 9;
    const int tc = r % NCH, b = r / NCH;
    const int jb = tc < 4 ? 3 - tc : 135 - tc;
    const int mbase = b * TPB + tc * 64;
    float2 cv = *(const float2*)(ci + ((size_t)(b * 2 + 1) * NCH + jb) * 1024 + ch);
    float c0 = cv.x, c1 = cv.y;
    {
      const bfu* lp = la + ((size_t)(mbase + 63) * 2 + 1) * 1024 + ch;
      const bfu* bp = bb + ((size_t)(mbase + 63) * 2 + 1) * 1024 + ch;
      bfu* yp = y + (size_t)(mbase + 63) * 1024 + ch;
      for (int t8 = 0; t8 < 64; t8 += 16) {
        uint32_t lv[16], bv[16];
#pragma unroll
        for (int u = 0; u < 16; ++u) { lv[u] = *(const uint32_t*)(lp - (t8 + u) * 2048); bv[u] = *(const uint32_t*)(bp - (t8 + u) * 2048); }
#pragma unroll
        for (int u = 0; u < 16; ++u) {
          c0 = __expf(__uint_as_float(lv[u] << 16)) * c0 + __uint_as_float(bv[u] << 16);
          c1 = __expf(__uint_as_float(lv[u] & 0xffff0000u)) * c1 + __uint_as_float(bv[u] & 0xffff0000u);
          *(uint32_t*)(yp - (t8 + u) * 1024) = pack2(c0, c1);
        }
      }
    }
    cv = *(const float2*)(ci + ((size_t)(b * 2 + 0) * NCH + tc) * 1024 + ch);
    c0 = cv.x; c1 = cv.y;
    {
      const bfu* lp = la + ((size_t)mbase * 2 + 0) * 1024 + ch;
      const bfu* bp = bb + ((size_t)mbase * 2 + 0) * 1024 + ch;
      bfu* yp = y + (size_t)mbase * 1024 + ch;
      const bfu* sp = sg + (size_t)mbase * 1024 + ch;
      for (int t8 = 0; t8 < 64; t8 += 16) {
        uint32_t lv[16], bv[16], yv[16], sv[16];
#pragma unroll
        for (int u = 0; u < 16; ++u) {
          lv[u] = *(const uint32_t*)(lp + (t8 + u) * 2048); bv[u] = *(const uint32_t*)(bp + (t8 + u) * 2048);
          yv[u] = *(const uint32_t*)(yp + (t8 + u) * 1024); sv[u] = *(const uint32_t*)(sp + (t8 + u) * 1024);
        }
#pragma unroll
        for (int u = 0; u < 16; ++u) {
          c0 = __expf(__uint_as_float(lv[u] << 16)) * c0 + __uint_as_float(bv[u] << 16);
          c1 = __expf(__uint_as_float(lv[u] & 0xffff0000u)) * c1 + __uint_as_float(bv[u] & 0xffff0000u);
          const float o0 = (c0 + __uint_as_float(yv[u] << 16)) * __uint_as_float(sv[u] << 16);
          const float o1 = (c1 + __uint_as_float(yv[u] & 0xffff0000u)) * __uint_as_float(sv[u] & 0xffff0000u);
          *(uint32_t*)(yp + (t8 + u) * 1024) = pack2(o0, o1);
        }
      }
    }
  }
}

struct BaseIdent { DI long operator()(int r) const { return r; } };
struct BaseGdnIn { DI long operator()(int r) const { return r < 4096 ? (long)r : (r < 4160 ? (long)(6144 + r - 4096) : -1L); } };
struct BaseGdnZ { DI long operator()(int r) const { return 4096 + r; } };
struct BaseLruGate {
  int kind;
  DI long operator()(int r) const {
    const int k = (r >> 5) & 1;
    if (k != kind) return -1L;
    const int cc = r & 31, grp = r >> 6;
    const int cg8 = grp & 7, d = (grp >> 3) & 1, nb = grp >> 4;
    return (long)(d * 4 + nb) * 65536 + cg8 * 32 + cc;
  }
};

DI void lru_gate_transpose(const float* wr, const float* wi, bfu* dst, char* smem) {
  float* tile = (float*)smem;
  const int tid = opaque_tid();
  for (int t = opaque_bid(); t < 64 * 4; t += gridDim.x) {
    const int r0 = (t >> 2) * 64, k0 = (t & 3) * 64;
    {
      const int rr = tid & 63;
      const long b_r = BaseLruGate{0}(r0 + rr), b_i = BaseLruGate{1}(r0 + rr);
      const float* src = b_r >= 0 ? wr + b_r : wi + b_i;
#pragma unroll
      for (int i = 0; i < 8; ++i) {
        const int kk = i * 8 + (tid >> 6);
        tile[kk * 65 + rr] = src[(long)(k0 + kk) * 256];
      }
    }
    __syncthreads();
#pragma unroll
    for (int i = 0; i < 8; ++i) {
      const int e = i * 512 + tid;
      const int rr = e >> 6, kk = e & 63;
      dst[(size_t)(r0 + rr) * 256 + k0 + kk] = f2bf(tile[kk * 65 + rr]);
    }
    __syncthreads();
  }
}

__global__ void __launch_bounds__(NTHR) fwd_megakernel(Params p) {
  cg::grid_group grid = cg::this_grid();
  __shared__ __attribute__((aligned(16))) char smem[151552];
  __shared__ uint4 xb_words;
  if (threadIdx.x == 0) xb_words = make_uint4(0u, 0u, 0u, 0u);
  __syncthreads();
  const XcdBarrier gbar = xcd_barrier_post((unsigned*)(p.ws + OFF_BAR), (volatile LAS unsigned*)&xb_words);
  char* ws = p.ws;
  float* mod = (float*)(ws + OFF_MOD);
  float* ctxres = (float*)(ws + OFF_CTXRES);
  bfu* wt = (bfu*)(ws + OFF_WT);
  bfu* h = (bfu*)(ws + OFF_H);

  mod_phase(p, mod, smem);
  transpose_phase(p.gdn_w_in, 6208, 1024, 4224, wt, BaseGdnIn(), smem);
  for (int i = opaque_bid() * NTHR + opaque_tid(); i < 512 * 1024 / 4; i += gridDim.x * NTHR)
    ((float4*)ctxres)[i] = ((const float4*)p.ctx)[i];
  grid.sync();

  unsigned lb_count = 0;
  for (int layer = 0; layer < 4; ++layer) {
    const int j = layer >> 1;
    const bool colmajor = ((layer + layer / 2) & 1) == 1;
    const float* xsrc = layer == 0 ? p.x : p.out;
    const float* modl = mod + (size_t)layer * 3 * 3072;
    if ((layer & 1) == 0) {
      bfu* proj = (bfu*)(ws + OFF_PROJ);
      bfu* halo = (bfu*)(ws + OFF_HALO);
      bfu* o = (bfu*)(ws + OFF_O);
      bfu* octx2 = (bfu*)(ws + OFF_OCTX2);
      float* gab = (float*)(ws + OFF_GG);
      const float* w_in = p.gdn_w_in + (size_t)j * 1024 * 6208;
      if (layer != 0) transpose_phase(w_in, 6208, 1024, 4224, wt, BaseGdnIn(), smem);
      norm_phase(xsrc, ctxres, p.norm_g + layer * 1024, modl, colmajor, h);
      xcd_barrier(gbar);
      gemm_phase(h, 1024, wt, 1024, 1024, 68, 33, KOffZero(),
                 EpiGdn1Conv{proj, gab, p.gdn_conv + (size_t)j * 4 * 4096}, smem, true);
      xcd_barrier(gbar);
      gdn_chunked(proj, gab, p.gdn_a_log + j * 32, p.gdn_dt_bias + j * 32, h, (float*)halo, o, octx2, smem, gbar, lb_count);
      norm_phase(xsrc, ctxres, p.norm_g + layer * 1024, modl, colmajor, h);
      transpose_phase(w_in, 6208, 1024, 2048, wt, BaseGdnZ(), smem);
      transpose_phase(p.gdn_w_out + (size_t)j * 2048 * 1024, 1024, 2048, 1024, wt + 2048 * 1024, BaseIdent(), smem);
      xcd_barrier(gbar);
      gemm_phase(h, 1024, wt, 1024, 1024, 66, 16, KOffZero(), EpiZGate{o, octx2, p.gdn_norm_g + j * 128}, smem);
      xcd_barrier(gbar);
      gemm_phase(o, 2048, wt + 2048 * 1024, 2048, 2048, 66, 8, KOffZero(),
                 EpiResid{xsrc, p.out, ctxres, modl, colmajor, layer < 3}, smem);
      xcd_barrier(gbar);
    } else {
      bfu* xb = (bfu*)(ws + OFF_XB);
      bfu* sg = (bfu*)(ws + OFF_SG);
      bfu* la = (bfu*)(ws + OFF_LA);
      bfu* bb = (bfu*)(ws + OFF_BB);
      float* cp = (float*)(ws + OFF_CP);
      float* chh = (float*)(ws + OFF_CH);
      float* ci = (float*)(ws + OFF_CI);
      bfu* xc = xb;
      bfu* yin = h;
      bfu* wt_in = wt;
      bfu* wt_gate = wt + 2048 * 1024;
      bfu* wt_out = wt_gate + 4096 * 256;
      transpose_phase(p.lru_w_in + (size_t)j * 1024 * 2048, 2048, 1024, 2048, wt_in, BaseIdent(), smem);
      lru_gate_transpose(p.lru_w_r + (size_t)j * 2 * 4 * 65536, p.lru_w_i + (size_t)j * 2 * 4 * 65536, wt_gate, smem);
      transpose_phase(p.lru_w_out + (size_t)j * 1024 * 1024, 1024, 1024, 1024, wt_out, BaseIdent(), smem);
      norm_phase(xsrc, ctxres, p.norm_g + layer * 1024, modl, colmajor, h);
      float* spl = (float*)(ws + OFF_SPL);
      for (int i = opaque_bid() * NTHR + opaque_tid(); i < 2048; i += gridDim.x * NTHR) spl[i] = softplus_f(-p.lru_lambda[j * 2048 + i]);
      xcd_barrier(gbar);
      gemm_phase(h, 1024, wt_in, 1024, 1024, 68, 16, KOffZero(),
                 EpiLruInConv{xc, sg, p.lru_conv_w + (size_t)j * 4 * 1024, p.lru_conv_b + j * 1024}, smem, true);
      xcd_barrier(gbar);
      gemm_phase(xc, 1024, wt_gate, 256, 256, 66, 32, KOffLruGate(),
                 EpiLruGate{xc, la, bb, p.lru_b_r + j * 2048, p.lru_b_i + j * 2048, spl}, smem);
      xcd_barrier(gbar);
      lru_scan1(la, bb, cp, chh);
      xcd_barrier(gbar);
      lru_scan2(cp, chh, ci, smem);
      xcd_barrier(gbar);
      lru_scan3(la, bb, ci, sg, yin);
      xcd_barrier(gbar);
      gemm_phase(yin, 1024, wt_out, 1024, 1024, 66, 8, KOffZero(),
                 EpiResid{xsrc, p.out, ctxres, modl, colmajor, layer < 3}, smem);
      xcd_barrier(gbar);
    }
  }
  final_norm_phase(p.out, p.final_g);
}

extern "C" void kernel_launch(void* const* d_in, const int* in_sizes, int n_in, void* d_out, int out_size, void* d_ws,
                              size_t ws_size, hipStream_t stream) {
  static int grid_blocks = 0;
  if (!grid_blocks) {
    int dev = 0, cus = 0, per_cu = 0;
    (void)hipGetDevice(&dev);
    (void)hipDeviceGetAttribute(&cus, hipDeviceAttributeMultiprocessorCount, dev);
    (void)hipOccupancyMaxActiveBlocksPerMultiprocessor(&per_cu, fwd_megakernel, NTHR, 0);
    if (per_cu > 1) per_cu = 1;
    grid_blocks = cus * per_cu;
  }
  Params p{};
  p.x = (const float*)d_in[0]; p.c = (const float*)d_in[1]; p.ctx = (const float*)d_in[2]; p.c_ctx = (const float*)d_in[3];
  p.mod_w = (const float*)d_in[4]; p.mod_b = (const float*)d_in[5]; p.norm_g = (const float*)d_in[6];
  p.gdn_w_in = (const float*)d_in[7]; p.gdn_conv = (const float*)d_in[8]; p.gdn_a_log = (const float*)d_in[9];
  p.gdn_dt_bias = (const float*)d_in[10]; p.gdn_norm_g = (const float*)d_in[11]; p.gdn_w_out = (const float*)d_in[12];
  p.lru_w_in = (const float*)d_in[13]; p.lru_conv_w = (const float*)d_in[14]; p.lru_conv_b = (const float*)d_in[15];
  p.lru_w_r = (const float*)d_in[16]; p.lru_b_r = (const float*)d_in[17]; p.lru_w_i = (const float*)d_in[18];
  p.lru_b_i = (const float*)d_in[19]; p.lru_lambda = (const float*)d_in[20]; p.lru_w_out = (const float*)d_in[21];
  p.final_g = (const float*)d_in[22];
  p.out = (float*)d_out;
  p.ws = (char*)d_ws;
  (void)hipMemsetAsync((char*)d_ws + OFF_BAR, 0, 16384, stream);
  void* args[] = {&p};
  hipError_t e = hipLaunchCooperativeKernel((void*)fwd_megakernel, dim3(grid_blocks), dim3(NTHR), args, 0, stream);
  if (e != hipSuccess) fprintf(stderr, "cooperative launch failed: %s (grid %d)\n", hipGetErrorString(e), grid_blocks);
}
```
